# Optimizing an MI355X kernel written in HIP

```python
import jax, jax.numpy as jnp
from jax import lax
import numpy as np

D_MODEL = 2048
BATCH = 1
SEQ = 8192
DEPTH = 2

GRID_W = 64
CTX_LEN = 256
HEAD_DIM = 128
MIX_WIDTH = D_MODEL
N_GROUP_HEADS = MIX_WIDTH // (2 * HEAD_DIM)
EPS = 1e-6
A_HEADS = N_GROUP_HEADS
A_WIDTH = A_HEADS * HEAD_DIM
CONV_W = 3
B_HEADS = N_GROUP_HEADS
B_KEY_DIM = HEAD_DIM // 2
B_KEY_WIDTH = B_HEADS * B_KEY_DIM
B_VAL_WIDTH = B_HEADS * HEAD_DIM
GLA_RANK = 16
GLA_TAU = 16.0
SCAN_CHUNK = 64
C_HEADS = N_GROUP_HEADS
C_WIDTH = C_HEADS * HEAD_DIM
WIN_H = 8
WIN_W = 16
D_HEADS = N_GROUP_HEADS
D_KV_HEADS = 2
D_GROUP = D_HEADS // D_KV_HEADS
D_WIDTH = D_HEADS * HEAD_DIM
D_KV_WIDTH = D_KV_HEADS * HEAD_DIM
WINDOW = 128
ROPE_BASE = 10000.0
PEER_HEADS = 8
PEER_NKEYS = 128
PEER_EXPERTS = PEER_NKEYS * PEER_NKEYS
PEER_QDIM = 256
PEER_TOPK = 16
PEER_BLOCK = 128
N_EVEN = (DEPTH + 1) // 2
N_ODD = DEPTH // 2
AB_SPLITS = (A_WIDTH, A_WIDTH, A_WIDTH, A_WIDTH, 4 * A_HEADS,
             B_KEY_WIDTH, B_KEY_WIDTH, B_VAL_WIDTH, B_VAL_WIDTH, 2 * GLA_RANK)
AB_COLS = sum(AB_SPLITS)
CD_SPLITS = (C_WIDTH, C_WIDTH, D_KV_WIDTH, D_KV_WIDTH, C_WIDTH, D_WIDTH)
CD_KV_COLS = sum(CD_SPLITS[:4])
CD_COLS = sum(CD_SPLITS)

kernel_name = 'hybrid_mlstm_gla_natten_swa_peer'


def split_cols(p, sizes):
    return jnp.split(p, np.cumsum(sizes)[:-1].tolist(), axis=-1)


def rmsnorm(x, g):
    xf = x.astype(jnp.float32)
    y = xf * lax.rsqrt(jnp.mean(xf * xf, axis=-1, keepdims=True) + EPS)
    return (y * g.astype(jnp.float32)).astype(x.dtype)


def modulate(x, g, shift, scale):
    return rmsnorm(x, g) * (1 + scale) + shift


def heads(t, hd):
    return t.reshape(t.shape[0], t.shape[1], -1, hd)


def short_conv(x, w, b):
    pad = CONV_W // 2
    n = x.shape[1]
    xp = jnp.pad(x, ((0, 0), (pad, pad), (0, 0)))
    return sum(w[j] * xp[:, j:j + n] for j in range(CONV_W)) + b


def to_chunks(t):
    B_, H_, n = t.shape[:3]
    return jnp.moveaxis(t.reshape(B_, H_, n // SCAN_CHUNK, SCAN_CHUNK, *t.shape[3:]), 2, 0)


def from_chunks(t):
    nc, B_, H_, L = t.shape[:4]
    return jnp.moveaxis(t, 0, 2).reshape(B_, H_, nc * L, *t.shape[4:])


def mlstm_scan(q, k, v, ig, lf, state):
    q, k, v, ig, lf = (t.astype(jnp.float32) for t in (q, k, v, ig, lf))
    mask = jnp.tril(jnp.ones((SCAN_CHUNK, SCAN_CHUNK), bool))

    def step(carry, inp):
        C, nv, m = carry
        qc, kc, vc, ic, fc = inp
        b = jnp.cumsum(fc, axis=-1)
        dlog = jnp.where(mask, b[..., :, None] - b[..., None, :] + ic[..., None, :], -jnp.inf)
        m_inter = b + m[..., None]
        m_t = jnp.maximum(m_inter, jnp.max(dlog, axis=-1))
        sc = jnp.einsum('bhtd,bhsd->bhts', qc, kc) * jnp.exp(dlog - m_t[..., None])
        w_inter = jnp.exp(m_inter - m_t)
        num = jnp.einsum('bhts,bhse->bhte', sc, vc) + w_inter[..., None] * jnp.einsum('bhtd,bhde->bhte', qc, C)
        den = jnp.sum(sc, axis=-1) + w_inter * jnp.einsum('bhtd,bhd->bht', qc, nv)
        h = num / jnp.maximum(jnp.abs(den), jnp.exp(-m_t))[..., None]
        m_new = m_t[..., -1]
        w_end = jnp.exp(b[..., -1:] - b + ic - m_new[..., None])
        decay = jnp.exp(b[..., -1] + m - m_new)
        C = decay[..., None, None] * C + jnp.einsum('bhs,bhsd,bhse->bhde', w_end, kc, vc)
        nv = decay[..., None] * nv + jnp.einsum('bhs,bhsd->bhd', w_end, kc)
        return (C, nv, m_new), h

    state, h = lax.scan(step, state, tuple(to_chunks(t) for t in (q, k, v, ig, lf)))
    return from_chunks(h), state


def gla_scan(q, k, v, lg, S0):
    q, k, v, lg = (t.astype(jnp.float32) for t in (q, k, v, lg))
    mask = jnp.tril(jnp.ones((SCAN_CHUNK, SCAN_CHUNK), bool))[:, :, None]

    def step(S, inp):
        qc, kc, vc, gc = inp
        b = jnp.cumsum(gc, axis=2)
        rel = jnp.where(mask, b[:, :, :, None, :] - b[:, :, None, :, :], -jnp.inf)
        attn = jnp.einsum('bhtd,bhtsd,bhsd->bhts', qc, jnp.exp(rel), kc)
        o = jnp.einsum('bhts,bhse->bhte', attn, vc) + jnp.einsum('bhtd,bhde->bhte', qc * jnp.exp(b), S)
        b_end = b[:, :, -1:, :]
        S = jnp.exp(b_end[:, :, 0])[..., None] * S + jnp.einsum('bhsd,bhse->bhde', kc * jnp.exp(b_end - b), vc)
        return S, o

    S, o = lax.scan(step, S0, tuple(to_chunks(t) for t in (q, k, v, lg)))
    return from_chunks(o), S


def bidirectional(scan_fn, init, ctx_seq, ctx_gates, lat_seq, lat_gates):
    y_c, y_l = None, None
    for z in range(2):
        fc = tuple(ctx_seq) + tuple(g[z] for g in ctx_gates)
        fl = tuple(lat_seq) + tuple(g[z] for g in lat_gates)
        if z == 1:
            fc = tuple(jnp.flip(t, axis=2) for t in fc)
            fl = tuple(jnp.flip(t, axis=2) for t in fl)
        oc, st = scan_fn(*fc, init)
        ol, _ = scan_fn(*fl, st)
        if z == 1:
            oc, ol = jnp.flip(oc, axis=2), jnp.flip(ol, axis=2)
        y_c = oc if y_c is None else y_c + oc
        y_l = ol if y_l is None else y_l + ol
    return y_c, y_l


def head_out(y, g, gate):
    B_, H_, n, hd = y.shape
    yn = rmsnorm(y.transpose(0, 2, 1, 3), g)
    return (yn * gate.reshape(B_, n, H_, hd)).reshape(B_, n, H_ * hd)


def ab_features(h, w_in, conv_w, conv_b, gate_b, alpha_w2, alpha_b):
    B_, n, _ = h.shape
    a_q, a_k, a_v, a_o, a_gate, b_q, b_k, b_v, b_r, b_lr = split_cols(h @ w_in, AB_SPLITS)
    a_qk = jax.nn.silu(short_conv(jnp.concatenate([a_q, a_k], axis=-1), conv_w, conv_b))
    a_q, a_k = jnp.split(a_qk, 2, axis=-1)
    bhnd = lambda t, hd: heads(t, hd).transpose(0, 2, 1, 3)
    g = (a_gate.reshape(B_, n, 2, 2, A_HEADS).astype(jnp.float32) + gate_b.astype(jnp.float32)).transpose(2, 3, 0, 4, 1)
    ig, lf = g[:, 0], jax.nn.log_sigmoid(g[:, 1])
    za = jnp.einsum('bnzr,zrc->zbnc', b_lr.reshape(B_, n, 2, GLA_RANK), alpha_w2) + alpha_b[:, None, None, :]
    lg = (jax.nn.log_sigmoid(za.astype(jnp.float32)) / GLA_TAU).reshape(2, B_, n, B_HEADS, B_KEY_DIM).transpose(0, 1, 3, 2, 4)
    a_seq = (bhnd(a_q, HEAD_DIM), bhnd(a_k, HEAD_DIM) * HEAD_DIM ** -0.5, bhnd(a_v, HEAD_DIM))
    b_seq = (bhnd(b_q, B_KEY_DIM) * B_KEY_DIM ** -0.5, bhnd(b_k, B_KEY_DIM), bhnd(b_v, HEAD_DIM))
    return a_seq, (ig, lf), a_o, b_seq, (lg,), b_r


def mixer_ab(h_c, h_l, w_in, conv_w, conv_b, gate_b, alpha_w2, alpha_b, head_g, w_out, need_ctx):
    fc = ab_features(h_c, w_in, conv_w, conv_b, gate_b, alpha_w2, alpha_b)
    fl = ab_features(h_l, w_in, conv_w, conv_b, gate_b, alpha_w2, alpha_b)
    B_ = h_l.shape[0]
    a_init = (jnp.zeros((B_, A_HEADS, HEAD_DIM, HEAD_DIM), jnp.float32),
              jnp.zeros((B_, A_HEADS, HEAD_DIM), jnp.float32),
              jnp.zeros((B_, A_HEADS), jnp.float32))
    b_init = jnp.zeros((B_, B_HEADS, B_KEY_DIM, HEAD_DIM), jnp.float32)
    a_c, a_l = bidirectional(mlstm_scan, a_init, fc[0], fc[1], fl[0], fl[1])
    b_c, b_l = bidirectional(gla_scan, b_init, fc[3], fc[4], fl[3], fl[4])

    def merge(a, b, a_o, b_r):
        ya = head_out(a, head_g[0], jax.nn.sigmoid(a_o))
        yb = head_out(b, head_g[1], jax.nn.silu(b_r))
        return jnp.concatenate([ya, yb], axis=-1).astype(a_o.dtype) @ w_out

    y_l = merge(a_l, b_l, fl[2], fl[5])
    y_c = merge(a_c, b_c, fc[2], fc[5]) if need_ctx else None
    return y_c, y_l


def rope_2d(x, row, col):
    d = x.shape[-1]

    def rope_axis(t, pos):
        half = t.shape[-1] // 2
        freqs = ROPE_BASE ** (-jnp.arange(half, dtype=jnp.float32) / half)
        ang = pos.astype(jnp.float32)[:, None] * freqs
        cos, sin = jnp.cos(ang)[:, None, :], jnp.sin(ang)[:, None, :]
        t1, t2 = t[..., :half], t[..., half:]
        return jnp.concatenate([t1 * cos - t2 * sin, t1 * sin + t2 * cos], axis=-1)

    return jnp.concatenate([rope_axis(x[..., :d // 2], row), rope_axis(x[..., d // 2:], col)], axis=-1).astype(x.dtype)


def ctx_attention(q, k, v, sink=None):
    B_, m, hq, d = q.shape
    hkv = k.shape[2]
    qg = q.reshape(B_, m, hkv, hq // hkv, d)
    s = jnp.einsum('bqkgd,bckd->bkgqc', qg, k).astype(jnp.float32)
    if sink is not None:
        s_sink = jnp.broadcast_to(sink.reshape(hkv, hq // hkv)[None, :, :, None, None].astype(jnp.float32), s.shape[:-1] + (1,))
        s = jnp.concatenate([s, s_sink], axis=-1)
    p = jax.nn.softmax(s, axis=-1)[..., :k.shape[1]].astype(v.dtype)
    return jnp.einsum('bkgqc,bckd->bqkgd', p, v).reshape(B_, m, hq, d)


def neighbourhood_attention(q, k, v, k_ctx, v_ctx, rpb):
    B_, n, H_, d = q.shape
    rows = n // GRID_W
    kh, kw = min(WIN_H, rows), WIN_W
    qg, kg, vg = (t.reshape(B_, rows, GRID_W, H_, d) for t in (q, k, v))
    cols = jnp.arange(GRID_W)
    col_start = jnp.clip(cols - kw // 2, 0, GRID_W - kw)
    col_idx = col_start[:, None] + jnp.arange(kw)[None, :]
    col_bias_idx = col_idx - cols[:, None] + (WIN_W - 1)

    def one_row(r):
        rs = jnp.clip(r - kh // 2, 0, rows - kh)
        k_nb = lax.dynamic_slice_in_dim(kg, rs, kh, axis=1)[:, :, col_idx]
        v_nb = lax.dynamic_slice_in_dim(vg, rs, kh, axis=1)[:, :, col_idx]
        q_r = lax.dynamic_index_in_dim(qg, r, axis=1, keepdims=False)
        row_bias_idx = rs + jnp.arange(kh) - r + (WIN_H - 1)
        bias = rpb[:, row_bias_idx][:, :, col_bias_idx].transpose(0, 2, 1, 3).reshape(H_, GRID_W, kh * kw)
        s_nb = jnp.einsum('bwhd,biwjhd->bhwij', q_r, k_nb).reshape(B_, H_, GRID_W, kh * kw)
        s_ctx = jnp.einsum('bwhd,bchd->bhwc', q_r, k_ctx)
        s = jnp.concatenate([s_nb.astype(jnp.float32) + bias.astype(jnp.float32), s_ctx.astype(jnp.float32)], axis=-1)
        p = jax.nn.softmax(s, axis=-1).astype(v.dtype)
        p_nb = p[..., :kh * kw].reshape(B_, H_, GRID_W, kh, kw)
        return (jnp.einsum('bhwij,biwjhd->bwhd', p_nb, v_nb)
                + jnp.einsum('bhwc,bchd->bwhd', p[..., kh * kw:], v_ctx))

    out = lax.map(one_row, jnp.arange(rows))
    return jnp.moveaxis(out, 0, 1).reshape(B_, n, H_, d)


def window_gqa(q, k, v, k_ctx, v_ctx, sink):
    B_, n, _, d = q.shape
    nb = n // WINDOW

    def bands(t):
        tp = jnp.pad(t, ((0, 0), (WINDOW, WINDOW), (0, 0), (0, 0))).reshape(B_, nb + 2, WINDOW, D_KV_HEADS, d)
        return jnp.concatenate([tp[:, :-2], tp[:, 1:-1], tp[:, 2:]], axis=2)

    kb, vb = bands(k), bands(v)
    qb = q.reshape(B_, nb, WINDOW, D_KV_HEADS, D_GROUP, d)
    s_win = jnp.einsum('bnqkgd,bnjkd->bnkgqj', qb, kb).astype(jnp.float32)
    s_ctx = jnp.einsum('bnqkgd,bckd->bnkgqc', qb, k_ctx).astype(jnp.float32)
    qi = jnp.arange(WINDOW)[:, None]
    kj = jnp.arange(3 * WINDOW)[None, :]
    key_pos = (jnp.arange(nb)[:, None, None] - 1) * WINDOW + kj[None]
    allowed = (jnp.abs(kj - qi - WINDOW) <= WINDOW)[None] & (key_pos >= 0) & (key_pos < n)
    s_win = jnp.where(allowed[None, :, None, None], s_win, -jnp.inf)
    s_sink = jnp.broadcast_to(sink.reshape(D_KV_HEADS, D_GROUP)[None, None, :, :, None, None].astype(jnp.float32),
                              s_win.shape[:-1] + (1,))
    p = jax.nn.softmax(jnp.concatenate([s_win, s_ctx, s_sink], axis=-1), axis=-1).astype(v.dtype)
    nw, nc = 3 * WINDOW, k_ctx.shape[1]
    out = (jnp.einsum('bnkgqj,bnjkd->bnqkgd', p[..., :nw], vb)
           + jnp.einsum('bnkgqc,bckd->bnqkgd', p[..., nw:nw + nc], v_ctx))
    return out.reshape(B_, n, D_HEADS, d)


def mixer_cd(h_c, h_l, w_in, qk_g, rpb, sink, w_out, need_ctx):
    B_, n, _ = h_l.shape
    scale = HEAD_DIM ** -0.5
    ck_l, cv_l, dk_l, dv_l, cq_l, dq_l = split_cols(h_l @ w_in, CD_SPLITS)
    if need_ctx:
        ck_c, cv_c, dk_c, dv_c, cq_c, dq_c = split_cols(h_c @ w_in, CD_SPLITS)
    else:
        ck_c, cv_c, dk_c, dv_c = split_cols(h_c @ w_in[:, :CD_KV_COLS], CD_SPLITS[:4])
    ck_c, dk_c = rmsnorm(heads(ck_c, HEAD_DIM), qk_g[1]), rmsnorm(heads(dk_c, HEAD_DIM), qk_g[3])
    cv_c, dv_c = heads(cv_c, HEAD_DIM), heads(dv_c, HEAD_DIM)
    t = jnp.arange(n)
    row, col = t // GRID_W, t % GRID_W
    cq = rmsnorm(heads(cq_l, HEAD_DIM), qk_g[0]) * scale
    ck = rmsnorm(heads(ck_l, HEAD_DIM), qk_g[1])
    dq = rope_2d(rmsnorm(heads(dq_l, HEAD_DIM), qk_g[2]), row, col) * scale
    dk = rope_2d(rmsnorm(heads(dk_l, HEAD_DIM), qk_g[3]), row, col)
    c_out = neighbourhood_attention(cq, ck, heads(cv_l, HEAD_DIM), ck_c, cv_c, rpb)
    d_out = window_gqa(dq, dk, heads(dv_l, HEAD_DIM), dk_c, dv_c, sink)
    y_l = jnp.concatenate([c_out.reshape(B_, n, C_WIDTH), d_out.reshape(B_, n, D_WIDTH)], axis=-1) @ w_out
    y_c = None
    if need_ctx:
        m = h_c.shape[1]
        cq_c = rmsnorm(heads(cq_c, HEAD_DIM), qk_g[0]) * scale
        dq_c = rmsnorm(heads(dq_c, HEAD_DIM), qk_g[2]) * scale
        c_ctx_out = ctx_attention(cq_c, ck_c, cv_c)
        d_ctx_out = ctx_attention(dq_c, dk_c, dv_c, sink)
        y_c = jnp.concatenate([c_ctx_out.reshape(B_, m, C_WIDTH), d_ctx_out.reshape(B_, m, D_WIDTH)], axis=-1) @ w_out
    return y_c, y_l


def peer(h, w_q, sub_keys, u, v_tab):
    B_, n, D = h.shape
    q = (h @ w_q).reshape(B_, n, PEER_HEADS, 2, PEER_QDIM // 2)
    s = jnp.einsum('bnhzd,hzkd->bnhzk', q, sub_keys).astype(jnp.float32)
    s1, i1 = lax.top_k(s[..., 0, :], PEER_TOPK)
    s2, i2 = lax.top_k(s[..., 1, :], PEER_TOPK)
    cand = (s1[..., :, None] + s2[..., None, :]).reshape(B_, n, PEER_HEADS, PEER_TOPK * PEER_TOPK)
    cidx = (i1[..., :, None] * PEER_NKEYS + i2[..., None, :]).reshape(B_, n, PEER_HEADS, PEER_TOPK * PEER_TOPK)
    best, pos = lax.top_k(cand, PEER_TOPK)
    eidx = jnp.take_along_axis(cidx, pos, axis=-1)
    g = jax.nn.softmax(best, axis=-1).astype(h.dtype)
    nb = (B_ * n) // PEER_BLOCK

    def block(args):
        hb, ib, gb = args
        act = jax.nn.gelu(jnp.einsum('td,ted->te', hb, u[ib]))
        return jnp.einsum('te,ted->td', gb * act, v_tab[ib])

    out = lax.map(block, (h.reshape(nb, PEER_BLOCK, D),
                          eidx.reshape(nb, PEER_BLOCK, PEER_HEADS * PEER_TOPK),
                          g.reshape(nb, PEER_BLOCK, PEER_HEADS * PEER_TOPK)))
    return out.reshape(B_, n, D)


def setup_inputs(seed: int = 0) -> dict:
    key = jax.random.key(seed)
    ks = jax.random.split(key, 24)
    D = D_MODEL
    nrm = lambda k, shape, s: jax.random.normal(k, shape, jnp.float32) * s
    f_bias = jnp.linspace(3.0, 6.0, A_HEADS, dtype=jnp.float32)
    if_bias = jnp.stack([jnp.zeros((A_HEADS,), jnp.float32), f_bias])
    return {
        'x': nrm(ks[0], (BATCH, SEQ, D), 1.0),
        'c': nrm(ks[1], (BATCH, D), 1.0),
        'ctx': nrm(ks[2], (BATCH, CTX_LEN, D), 1.0),
        'c_ctx': nrm(ks[3], (D,), 1.0),
        'mod_w': nrm(ks[4], (DEPTH, D, 6 * D), 0.5 * D ** -0.5),
        'mod_b': nrm(ks[5], (DEPTH, 6 * D), 0.02),
        'norm_g': 1.0 + nrm(ks[6], (DEPTH, 2, D), 0.02),
        'ab_w_in': nrm(ks[7], (N_EVEN, D, AB_COLS), D ** -0.5),
        'ab_conv_w': nrm(ks[8], (N_EVEN, CONV_W, 2 * A_WIDTH), CONV_W ** -0.5),
        'ab_conv_b': nrm(ks[9], (N_EVEN, 2 * A_WIDTH), 0.02),
        'ab_gate_b': nrm(ks[10], (N_EVEN, 2, 2, A_HEADS), 0.1) + if_bias[None, None],
        'ab_alpha_w2': nrm(ks[11], (N_EVEN, 2, GLA_RANK, B_KEY_WIDTH), GLA_RANK ** -0.5),
        'ab_alpha_b': 1.0 + nrm(ks[12], (N_EVEN, 2, B_KEY_WIDTH), 0.1),
        'ab_head_g': 1.0 + nrm(ks[13], (N_EVEN, 2, HEAD_DIM), 0.02),
        'ab_w_out': nrm(ks[14], (N_EVEN, MIX_WIDTH, D), MIX_WIDTH ** -0.5),
        'cd_w_in': nrm(ks[15], (N_ODD, D, CD_COLS), D ** -0.5),
        'cd_qk_g': 1.0 + nrm(ks[16], (N_ODD, 4, HEAD_DIM), 0.02),
        'cd_rpb': nrm(ks[17], (N_ODD, C_HEADS, 2 * WIN_H - 1, 2 * WIN_W - 1), 0.1),
        'cd_sink': nrm(ks[18], (N_ODD, D_HEADS), 1.0),
        'cd_w_out': nrm(ks[19], (N_ODD, MIX_WIDTH, D), MIX_WIDTH ** -0.5),
        'peer_w_q': nrm(ks[20], (DEPTH, D, PEER_HEADS * PEER_QDIM), D ** -0.5),
        'peer_sub_keys': nrm(ks[21], (DEPTH, PEER_HEADS, 2, PEER_NKEYS, PEER_QDIM // 2), (PEER_QDIM // 2) ** -0.5),
        'peer_u': nrm(ks[22], (DEPTH, PEER_EXPERTS, D), D ** -0.5),
        'peer_v': nrm(ks[23], (DEPTH, PEER_EXPERTS, D), 0.5),
    }


def reference(x, c, ctx, c_ctx, mod_w, mod_b, norm_g, ab_w_in, ab_conv_w, ab_conv_b, ab_gate_b, ab_alpha_w2,
              ab_alpha_b, ab_head_g, ab_w_out, cd_w_in, cd_qk_g, cd_rpb, cd_sink, cd_w_out, peer_w_q,
              peer_sub_keys, peer_u, peer_v):
    xl, xc = x, ctx
    for l in range(DEPTH):
        need_ctx = l < DEPTH - 1
        j = l // 2
        mod_l = jnp.split((jax.nn.silu(c) @ mod_w[l] + mod_b[l])[:, None, :], 6, axis=-1)
        mod_c = jnp.split((jax.nn.silu(c_ctx) @ mod_w[l] + mod_b[l])[None, None, :], 6, axis=-1)
        hl = modulate(xl, norm_g[l, 0], mod_l[0], mod_l[1])
        hc = modulate(xc, norm_g[l, 0], mod_c[0], mod_c[1])
        if l % 2 == 0:
            yc, yl = mixer_ab(hc, hl, ab_w_in[j], ab_conv_w[j], ab_conv_b[j], ab_gate_b[j], ab_alpha_w2[j],
                              ab_alpha_b[j], ab_head_g[j], ab_w_out[j], need_ctx)
        else:
            yc, yl = mixer_cd(hc, hl, cd_w_in[j], cd_qk_g[j], cd_rpb[j], cd_sink[j], cd_w_out[j], need_ctx)
        xl = xl + mod_l[2] * yl
        hl = modulate(xl, norm_g[l, 1], mod_l[3], mod_l[4])
        xl = xl + mod_l[5] * peer(hl, peer_w_q[l], peer_sub_keys[l], peer_u[l], peer_v[l])
        if need_ctx:
            xc = xc + mod_c[2] * yc
            hc = modulate(xc, norm_g[l, 1], mod_c[3], mod_c[4])
            xc = xc + mod_c[5] * peer(hc, peer_w_q[l], peer_sub_keys[l], peer_u[l], peer_v[l])
    return xl
```

```cpp
#include <hip/hip_runtime.h>
#include <cstdint>
#include <cstdio>

typedef unsigned short bf16_t;
typedef unsigned int u32;
typedef float f32x4 __attribute__((ext_vector_type(4)));
typedef unsigned u32x4 __attribute__((ext_vector_type(4)));
typedef unsigned u32x2 __attribute__((ext_vector_type(2)));

constexpr int NL = 8192, NC = 256, NT = 8448, DM = 2048;
constexpr int PAB_LD = 7424, PCD_LD = 4608;
constexpr int NTHR = 512;
constexpr int CA_Q = 0, CA_K = 1024, CA_V = 2048, CA_O = 3072, CA_G = 4096, CB_Q = 4128, CB_K = 4640, CB_V = 5152, CB_R = 6176, CB_LR = 7200;

constexpr size_t MiB = 1u << 20;
constexpr size_t OFF_CTL = 0, CTL_BYTES = 1 * MiB;
constexpr size_t OFF_MODV = 64 * 1024;
constexpr size_t OFF_H = 2 * MiB;
constexpr size_t OFF_YM = 36 * MiB;
constexpr size_t OFF_QP = 70 * MiB;
constexpr size_t OFF_XC = 104 * MiB;
constexpr size_t OFF_EIDX = 106 * MiB;
constexpr size_t OFF_EG = 111 * MiB;
constexpr size_t OFF_PAB = 116 * MiB;
constexpr size_t OFF_AQ = 236 * MiB;
constexpr size_t OFF_AK = 253 * MiB;
constexpr size_t OFF_AKT = 270 * MiB;
constexpr size_t OFF_AVT = 287 * MiB;
constexpr size_t OFF_IG = 306 * MiB;
constexpr size_t OFF_LF = 307 * MiB;
constexpr size_t OFF_BQS = 308 * MiB;
constexpr size_t OFF_BKS = 325 * MiB;
constexpr size_t OFF_BKENDT = 342 * MiB;
constexpr size_t OFF_BVT = 359 * MiB;
constexpr size_t OFF_GDEC = 376 * MiB;
constexpr size_t OFF_LG = 377 * MiB;
constexpr size_t OFF_YAD = 410 * MiB;
constexpr size_t OFF_YBD = 476 * MiB;
constexpr size_t OFF_TU0 = 592 * MiB, OFF_TV0 = 656 * MiB, OFF_TU1 = 720 * MiB, OFF_TV1 = 784 * MiB;
constexpr size_t OFF_CQ = 236 * MiB;
constexpr size_t OFF_CK = 253 * MiB;
constexpr size_t OFF_DQ = 287 * MiB;
constexpr size_t OFF_DK = 308 * MiB;

struct Params {
    const float *x, *c, *ctx, *c_ctx, *mod_w, *mod_b, *norm_g, *ab_w_in, *ab_conv_w, *ab_conv_b, *ab_gate_b, *ab_alpha_w2,
        *ab_alpha_b, *ab_head_g, *ab_w_out, *cd_w_in, *cd_qk_g, *cd_rpb, *cd_sink, *cd_w_out, *peer_w_q, *peer_sub_keys, *peer_u, *peer_v;
    float* out; unsigned char* ws;
};

__device__ __forceinline__ float bf2f(bf16_t v) { return __uint_as_float(((u32)v) << 16); }
__device__ __forceinline__ u32 f2bf(float f) { u32 u = __float_as_uint(f); return (u + 0x7fffu + ((u >> 16) & 1u)) >> 16; }
__device__ __forceinline__ u32 pk2(float lo, float hi) { return f2bf(lo) | (f2bf(hi) << 16); }
__device__ __forceinline__ float wave_sum(float v) {
#pragma unroll
    for (int o = 1; o < 64; o <<= 1) v += __shfl_xor(v, o);
    return v;
}
__device__ __forceinline__ float wave_max(float v) {
#pragma unroll
    for (int o = 1; o < 64; o <<= 1) v = fmaxf(v, __shfl_xor(v, o));
    return v;
}
__device__ __forceinline__ u32 wave_max_u32(u32 v) {
#pragma unroll
    for (int o = 1; o < 64; o <<= 1) { u32 t = (u32)__shfl_xor((int)v, o); v = t > v ? t : v; }
    return v;
}
__device__ __forceinline__ float siluf(float a) { return a / (1.f + __expf(-a)); }
__device__ __forceinline__ float sigmoidf_(float a) { return 1.f / (1.f + __expf(-a)); }
__device__ __forceinline__ float logsigf(float a) { return a < 0.f ? a - log1pf(__expf(a)) : -log1pf(__expf(-a)); }
__device__ __forceinline__ float gelu_tanh(float v) { return 0.5f * v * (1.f + tanhf(0.7978845608028654f * (v + 0.044715f * v * v * v))); }

__device__ void ph_mod(const Params& p, unsigned char* smem) {
    float* sc = (float*)smem;
    f32x4* red = (f32x4*)(smem + 16384);
    for (int i = threadIdx.x; i < 2048; i += NTHR) { sc[i] = siluf(p.c[i]); sc[2048 + i] = siluf(p.c_ctx[i]); }
    __syncthreads();
    float* modv = (float*)(p.ws + OFF_MODV);
    const int lane = threadIdx.x & 63, wave = threadIdx.x >> 6;
    constexpr int C4 = 3072;
    for (int u = blockIdx.x; u < 2 * 48; u += gridDim.x) {
        const int l = u / 48, c4 = (u % 48) * 64 + lane;
        const f32x4* W = (const f32x4*)(p.mod_w + (size_t)l * 2048 * 12288) + c4;
        f32x4 a0 = {0.f, 0.f, 0.f, 0.f}, a1 = {0.f, 0.f, 0.f, 0.f};
        const int k0 = wave * 256;
#pragma unroll 8
        for (int k = k0; k < k0 + 256; ++k) { const f32x4 w = W[(size_t)k * C4]; a0 += w * sc[k]; a1 += w * sc[2048 + k]; }
        red[wave * 64 + lane] = a0; red[512 + wave * 64 + lane] = a1;
        __syncthreads();
        if (wave < 2) {
            f32x4 s = *((const f32x4*)(p.mod_b + (size_t)l * 12288) + c4);
#pragma unroll
            for (int w = 0; w < 8; ++w) s += red[wave * 512 + w * 64 + lane];
            *(f32x4*)(modv + (size_t)(l * 2 + wave) * 12288 + c4 * 4) = s;
        }
        __syncthreads();
    }
}

__device__ void ph_conv_tables(const Params& p) {
    const size_t n8 = (size_t)16384 * 2048 / 8;
    const size_t gt = (size_t)blockIdx.x * NTHR + threadIdx.x, gs = (size_t)gridDim.x * NTHR;
    for (int t = 0; t < 4; ++t) {
        const int l = t >> 1; const float* src = ((t & 1) ? p.peer_v : p.peer_u) + (size_t)l * 16384 * 2048;
        bf16_t* dst = (bf16_t*)(p.ws + (t == 0 ? OFF_TU0 : t == 1 ? OFF_TV0 : t == 2 ? OFF_TU1 : OFF_TV1));
        for (size_t i = gt; i < n8; i += gs) {
            const f32x4 a = ((const f32x4*)src)[2 * i], b = ((const f32x4*)src)[2 * i + 1];
            u32x4 o; o.x = pk2(a.x, a.y); o.y = pk2(a.z, a.w); o.z = pk2(b.x, b.y); o.w = pk2(b.z, b.w);
            ((u32x4*)dst)[i] = o;
        }
    }
}

__device__ void ph_norm(const Params& p, int l, int a, const float* lat_src, const float* ctx_src, int nrows) {
    const int lane = threadIdx.x & 63, wave = threadIdx.x >> 6;
    const int gw = blockIdx.x * 8 + wave, NGW = gridDim.x * 8;
    const f32x4* g4 = (const f32x4*)(p.norm_g + (size_t)(l * 2 + a) * 2048);
    const float* modv = (const float*)(p.ws + OFF_MODV);
    bf16_t* H = (bf16_t*)(p.ws + OFF_H);
    for (int m = gw; m < nrows; m += NGW) {
        const bool isc = m >= NL;
        const f32x4* src = (const f32x4*)(isc ? ctx_src + (size_t)(m - NL) * DM : lat_src + (size_t)m * DM);
        const float* mv = modv + (size_t)(l * 2 + (isc ? 1 : 0)) * 12288 + (a ? 3 : 0) * 2048;
        const f32x4* sh4 = (const f32x4*)mv; const f32x4* sc4 = (const f32x4*)(mv + 2048);
        f32x4 v[8]; float ss = 0.f;
#pragma unroll
        for (int j = 0; j < 8; ++j) { v[j] = src[lane + 64 * j]; ss += v[j].x * v[j].x + v[j].y * v[j].y + v[j].z * v[j].z + v[j].w * v[j].w; }
        ss = wave_sum(ss);
        const float r = rsqrtf(ss * (1.f / 2048.f) + 1e-6f);
        u32x2* o = (u32x2*)(H + (size_t)m * DM);
#pragma unroll
        for (int j = 0; j < 8; ++j) {
            const int i4 = lane + 64 * j; const f32x4 gg = g4[i4], sh = sh4[i4], sc = sc4[i4];
            const f32x4 y = v[j] * r * gg * (sc + 1.f) + sh;
            u32x2 w; w.x = pk2(y.x, y.y); w.y = pk2(y.z, y.w); o[i4] = w;
        }
    }
}

struct EpiStoreBf16 {
    bf16_t* O; int ld;
    __device__ __forceinline__ void operator()(int m, int n, f32x4 v) const { u32x2 w; w.x = pk2(v.x, v.y); w.y = pk2(v.z, v.w); *(u32x2*)(O + (size_t)m * ld + n) = w; }
};
struct EpiResidual {
    const float* xin_lat; const float* xin_ctx; float* xout_lat; float* xout_ctx; const float* gate_lat; const float* gate_ctx;
    __device__ __forceinline__ void operator()(int m, int n, f32x4 v) const {
        if (m < NL) { const f32x4 b = *(const f32x4*)(xin_lat + (size_t)m * DM + n), g = *(const f32x4*)(gate_lat + n); *(f32x4*)(xout_lat + (size_t)m * DM + n) = b + g * v; }
        else { const int mc = m - NL; const f32x4 b = *(const f32x4*)(xin_ctx + (size_t)mc * DM + n), g = *(const f32x4*)(gate_ctx + n); *(f32x4*)(xout_ctx + (size_t)mc * DM + n) = b + g * v; }
    }
};
template <class Epi>
__device__ void ph_gemm_naive(const bf16_t* A, const float* W, int M, int N, const Epi& E, unsigned char* smem) {
    float* As = (float*)smem;
    float* Ws = As + 16 * 132;
    const int tid = threadIdx.x, ty = tid >> 4, tx = tid & 15;
    const int nTm = M / 128, nTn = N / 64, ntile = nTm * nTn;
    for (int t = blockIdx.x; t < ntile; t += gridDim.x) {
        const int tm = t % nTm, tn = t / nTm; const int m0 = tm * 128, n0 = tn * 64;
        f32x4 acc[4];
#pragma unroll
        for (int i = 0; i < 4; ++i) acc[i] = (f32x4){0.f, 0.f, 0.f, 0.f};
        for (int k0 = 0; k0 < 2048; k0 += 16) {
            { const int r = tid >> 2, kq = (tid & 3) * 4; const u32x2 a = *(const u32x2*)(A + (size_t)(m0 + r) * 2048 + k0 + kq);
              As[(kq + 0) * 132 + r] = __uint_as_float(a.x << 16); As[(kq + 1) * 132 + r] = __uint_as_float(a.x & 0xffff0000u);
              As[(kq + 2) * 132 + r] = __uint_as_float(a.y << 16); As[(kq + 3) * 132 + r] = __uint_as_float(a.y & 0xffff0000u); }
            { const int kk = tid >> 5, nn = (tid & 31) * 2; const float2 w = *(const float2*)(W + (size_t)(k0 + kk) * N + n0 + nn); Ws[kk * 64 + nn] = w.x; Ws[kk * 64 + nn + 1] = w.y; }
            __syncthreads();
#pragma unroll
            for (int k = 0; k < 16; ++k) {
                const f32x4 a = *(const f32x4*)(As + k * 132 + ty * 4); const f32x4 b = *(const f32x4*)(Ws + k * 64 + tx * 4);
                acc[0] += b * a.x; acc[1] += b * a.y; acc[2] += b * a.z; acc[3] += b * a.w;
            }
            __syncthreads();
        }
#pragma unroll
        for (int i = 0; i < 4; ++i) E(m0 + ty * 4 + i, n0 + tx * 4, acc[i]);
    }
}

__device__ void ph_prep_ab(const Params& p, unsigned char* smem) {
    const bf16_t* PAB = (const bf16_t*)(p.ws + OFF_PAB);
    bf16_t* AQ = (bf16_t*)(p.ws + OFF_AQ); bf16_t* AK = (bf16_t*)(p.ws + OFF_AK); bf16_t* AKT = (bf16_t*)(p.ws + OFF_AKT);
    bf16_t* AVT = (bf16_t*)(p.ws + OFF_AVT); bf16_t* BVT = (bf16_t*)(p.ws + OFF_BVT);
    const int tid = threadIdx.x;
    {
        bf16_t* tK = (bf16_t*)smem; bf16_t* tV = tK + 64 * 128; bf16_t* tB = tV + 64 * 128;
        for (int u = blockIdx.x; u < 132 * 8; u += gridDim.x) {
            const int tt = u >> 3, h = u & 7; const int m0 = tt * 64; const int lo = m0 < NL ? 0 : NL, hi = m0 < NL ? NL : NT;
            for (int e = tid; e < 64 * 128; e += NTHR) {
                const int tau = e >> 7, d = e & 127; const int m = m0 + tau;
                const bf16_t* row = PAB + (size_t)m * PAB_LD;
                const bool hm = (m - 1) >= lo, hp = (m + 1) < hi;
                {   const int ch = h * 128 + d;
                    const float xm = hm ? bf2f(row[ch - PAB_LD]) : 0.f, x0 = bf2f(row[ch]), xp = hp ? bf2f(row[ch + PAB_LD]) : 0.f;
                    float q = p.ab_conv_w[ch] * xm + p.ab_conv_w[2048 + ch] * x0 + p.ab_conv_w[4096 + ch] * xp + p.ab_conv_b[ch];
                    q = siluf(q); AQ[((size_t)h * NT + m) * 128 + d] = (bf16_t)f2bf(q); }
                {   const int ch = 1024 + h * 128 + d;
                    const float xm = hm ? bf2f(row[ch - PAB_LD]) : 0.f, x0 = bf2f(row[ch]), xp = hp ? bf2f(row[ch + PAB_LD]) : 0.f;
                    float k = p.ab_conv_w[ch] * xm + p.ab_conv_w[2048 + ch] * x0 + p.ab_conv_w[4096 + ch] * xp + p.ab_conv_b[ch];
                    k = siluf(k) * 0.08838834764831845f; const bf16_t kb = (bf16_t)f2bf(k);
                    AK[((size_t)h * NT + m) * 128 + d] = kb; tK[tau * 128 + d] = kb; }
                tV[tau * 128 + d] = row[CA_V + h * 128 + d];
                tB[tau * 128 + d] = row[CB_V + h * 128 + d];
            }
            __syncthreads();
            for (int e = tid; e < 128 * 8; e += NTHR) {
                const int d = e >> 3, c8 = e & 7;
                u32x4 ok, ov, ob; u32 tk[8], tv[8], tb[8];
#pragma unroll
                for (int j = 0; j < 8; ++j) { tk[j] = tK[(c8 * 8 + j) * 128 + d]; tv[j] = tV[(c8 * 8 + j) * 128 + d]; tb[j] = tB[(c8 * 8 + j) * 128 + d]; }
                ok.x = tk[0] | (tk[1] << 16); ok.y = tk[2] | (tk[3] << 16); ok.z = tk[4] | (tk[5] << 16); ok.w = tk[6] | (tk[7] << 16);
                ov.x = tv[0] | (tv[1] << 16); ov.y = tv[2] | (tv[3] << 16); ov.z = tv[4] | (tv[5] << 16); ov.w = tv[6] | (tv[7] << 16);
                ob.x = tb[0] | (tb[1] << 16); ob.y = tb[2] | (tb[3] << 16); ob.z = tb[4] | (tb[5] << 16); ob.w = tb[6] | (tb[7] << 16);
                *(u32x4*)(AKT + ((size_t)h * 128 + d) * NT + m0 + c8 * 8) = ok;
                *(u32x4*)(AVT + ((size_t)h * 144 + d) * NT + m0 + c8 * 8) = ov;
                *(u32x4*)(BVT + ((size_t)h * 128 + d) * NT + m0 + c8 * 8) = ob;
            }
            if (tid < 128) { const int rr = 128 + (tid >> 3), c8 = tid & 7; const u32 val = rr == 128 ? 0x3f803f80u : 0u;
                *(u32x4*)(AVT + ((size_t)h * 144 + rr) * NT + m0 + c8 * 8) = (u32x4){val, val, val, val}; }
            __syncthreads();
        }
    }
    {
        float* IG = (float*)(p.ws + OFF_IG); float* LF = (float*)(p.ws + OFF_LF);
        for (int i = blockIdx.x * NTHR + tid; i < NT * 32; i += gridDim.x * NTHR) {
            const int m = i >> 5, r = i & 31; const int z = r >> 4, g = (r >> 3) & 1, h = r & 7;
            const float val = bf2f(PAB[(size_t)m * PAB_LD + CA_G + r]) + p.ab_gate_b[r];
            if (g == 0) IG[(size_t)(z * 8 + h) * NT + m] = val; else LF[(size_t)(z * 8 + h) * NT + m] = logsigf(val);
        }
    }
    {
        float* blr = (float*)smem;
        bf16_t* BQS = (bf16_t*)(p.ws + OFF_BQS); bf16_t* BKS = (bf16_t*)(p.ws + OFF_BKS); bf16_t* BKENDT = (bf16_t*)(p.ws + OFF_BKENDT);
        float* GDEC = (float*)(p.ws + OFF_GDEC); float* LG = (float*)(p.ws + OFF_LG);
        const int cc = tid, h = tid >> 6, c = tid & 63;
        for (int u = blockIdx.x; u < 2 * 132; u += gridDim.x) {
            const int z = u / 132, tt = u % 132; const int m0 = tt * 64;
            __syncthreads();
            for (int e = tid; e < 64 * 16; e += NTHR) { const int tau = e >> 4, r = e & 15; blr[e] = bf2f(PAB[(size_t)(m0 + tau) * PAB_LD + CB_LR + z * 16 + r]); }
            __syncthreads();
            float aw[16];
#pragma unroll
            for (int r = 0; r < 16; ++r) aw[r] = p.ab_alpha_w2[(size_t)(z * 16 + r) * 512 + cc];
            const float ab = p.ab_alpha_b[z * 512 + cc];
            float B = 0.f;
            for (int tau = 0; tau < 64; ++tau) { float za = ab;
#pragma unroll
                for (int r = 0; r < 16; ++r) za += blr[tau * 16 + r] * aw[r];
                B += logsigf(za) * (1.f / 16.f); }
            float run = 0.f;
            for (int s = 0; s < 64; ++s) {
                const int tau = z ? 63 - s : s; float za = ab;
#pragma unroll
                for (int r = 0; r < 16; ++r) za += blr[tau * 16 + r] * aw[r];
                const float lg = logsigf(za) * (1.f / 16.f); run += lg;
                const int m = m0 + tau;
                const float qv = bf2f(PAB[(size_t)m * PAB_LD + CB_Q + cc]) * 0.125f, kv = bf2f(PAB[(size_t)m * PAB_LD + CB_K + cc]);
                BQS[((size_t)(z * 8 + h) * NT + m) * 64 + c] = (bf16_t)f2bf(qv * __expf(run));
                BKS[((size_t)(z * 8 + h) * NT + m) * 64 + c] = (bf16_t)f2bf(kv * __expf(-run));
                BKENDT[((size_t)(z * 8 + h) * 64 + c) * NT + m] = (bf16_t)f2bf(kv * __expf(B - run));
                LG[((size_t)z * NT + m) * 512 + cc] = lg;
            }
            GDEC[((size_t)(z * 8 + h) * 132 + tt) * 64 + c] = __expf(B);
        }
    }
}

__device__ __forceinline__ int scan_row(int z, int pos) { return z == 0 ? (pos < NC ? NL + pos : pos - NC) : (pos < NC ? NL + (NC - 1) - pos : (NL - 1) - (pos - NC)); }

__device__ void ph_mlstm_naive(const Params& p, unsigned char* smem) {
    const bf16_t* PAB = (const bf16_t*)(p.ws + OFF_PAB); const bf16_t* AQ = (const bf16_t*)(p.ws + OFF_AQ); const bf16_t* AK = (const bf16_t*)(p.ws + OFF_AK);
    const float* IG = (const float*)(p.ws + OFF_IG); const float* LF = (const float*)(p.ws + OFF_LF); float* YAD = (float*)(p.ws + OFF_YAD);
    float* qs = (float*)smem; float* ks = qs + 128; float* red = ks + 128; float* dred = red + 512;
    const int tid = threadIdx.x, dv = tid & 127, g4 = tid >> 7, wave = tid >> 6;
    for (int u = blockIdx.x; u < 16; u += gridDim.x) {
        const int z = u >> 3, h = u & 7;
        float C[32];
#pragma unroll
        for (int j = 0; j < 32; ++j) C[j] = 0.f;
        float nvec = 0.f;
        for (int pos = 0; pos < NT; ++pos) {
            const int m = scan_row(z, pos);
            if (tid < 128) qs[tid] = bf2f(AQ[((size_t)h * NT + m) * 128 + tid]); else if (tid < 256) ks[tid - 128] = bf2f(AK[((size_t)h * NT + m) * 128 + tid - 128]);
            const float ef = __expf(LF[(size_t)(z * 8 + h) * NT + m]), ei = __expf(IG[(size_t)(z * 8 + h) * NT + m]);
            const float v = bf2f(PAB[(size_t)m * PAB_LD + CA_V + h * 128 + dv]);
            __syncthreads();
            float part = 0.f;
#pragma unroll
            for (int j = 0; j < 32; ++j) { const int dk = g4 * 32 + j; C[j] = ef * C[j] + ei * ks[dk] * v; part += qs[dk] * C[j]; }
            red[g4 * 128 + dv] = part;
            if (tid < 128) { nvec = ef * nvec + ei * ks[tid]; const float dp = wave_sum(qs[tid] * nvec); if ((tid & 63) == 0) dred[wave] = dp; }
            __syncthreads();
            if (tid < 128) { const float num = red[tid] + red[128 + tid] + red[256 + tid] + red[384 + tid]; const float den = dred[0] + dred[1];
                YAD[((size_t)z * NT + m) * 1024 + h * 128 + tid] = num / fmaxf(fabsf(den), 1.f); }
            __syncthreads();
        }
    }
}
__device__ void ph_gla_naive(const Params& p, unsigned char* smem) {
    const bf16_t* PAB = (const bf16_t*)(p.ws + OFF_PAB); const float* LG = (const float*)(p.ws + OFF_LG); float* YBD = (float*)(p.ws + OFF_YBD);
    float* qs = (float*)smem; float* ks = qs + 64; float* ls = ks + 64; float* red = ls + 64;
    const int tid = threadIdx.x, dv = tid & 127, g4 = tid >> 7;
    for (int u = blockIdx.x; u < 16; u += gridDim.x) {
        const int z = u >> 3, h = u & 7;
        float S[16];
#pragma unroll
        for (int j = 0; j < 16; ++j) S[j] = 0.f;
        for (int pos = 0; pos < NT; ++pos) {
            const int m = scan_row(z, pos);
            if (tid < 64) qs[tid] = bf2f(PAB[(size_t)m * PAB_LD + CB_Q + h * 64 + tid]) * 0.125f;
            else if (tid < 128) ks[tid - 64] = bf2f(PAB[(size_t)m * PAB_LD + CB_K + h * 64 + tid - 64]);
            else if (tid < 192) ls[tid - 128] = __expf(LG[((size_t)z * NT + m) * 512 + h * 64 + tid - 128]);
            const float v = bf2f(PAB[(size_t)m * PAB_LD + CB_V + h * 128 + dv]);
            __syncthreads();
            float part = 0.f;
#pragma unroll
            for (int j = 0; j < 16; ++j) { const int dk = g4 * 16 + j; S[j] = ls[dk] * S[j] + ks[dk] * v; part += qs[dk] * S[j]; }
            red[g4 * 128 + dv] = part;
            __syncthreads();
            if (tid < 128) YBD[((size_t)z * NT + m) * 1024 + h * 128 + tid] = red[tid] + red[128 + tid] + red[256 + tid] + red[384 + tid];
            __syncthreads();
        }
    }
}
__device__ void ph_merge_ab(const Params& p) {
    const bf16_t* PAB = (const bf16_t*)(p.ws + OFF_PAB); const float* YAD = (const float*)(p.ws + OFF_YAD); const float* YBD = (const float*)(p.ws + OFF_YBD);
    bf16_t* YM = (bf16_t*)(p.ws + OFF_YM);
    const int lane = threadIdx.x & 63, wave = threadIdx.x >> 6;
    for (int j = blockIdx.x * 8 + wave; j < NT * 8; j += gridDim.x * 8) {
        const int m = j >> 3, h = j & 7; const int d = lane * 2;
        {   const float2 a0 = *(const float2*)(YAD + (size_t)m * 1024 + h * 128 + d), a1 = *(const float2*)(YAD + ((size_t)NT + m) * 1024 + h * 128 + d);
            const float y0 = a0.x + a1.x, y1 = a0.y + a1.y; const float r = rsqrtf(wave_sum(y0 * y0 + y1 * y1) * (1.f / 128.f) + 1e-6f);
            const u32 gt = *(const u32*)(PAB + (size_t)m * PAB_LD + CA_O + h * 128 + d);
            const float o0 = y0 * r * p.ab_head_g[d] * sigmoidf_(__uint_as_float(gt << 16)), o1 = y1 * r * p.ab_head_g[d + 1] * sigmoidf_(__uint_as_float(gt & 0xffff0000u));
            *(u32*)(YM + (size_t)m * DM + h * 128 + d) = pk2(o0, o1); }
        {   const float2 a0 = *(const float2*)(YBD + (size_t)m * 1024 + h * 128 + d), a1 = *(const float2*)(YBD + ((size_t)NT + m) * 1024 + h * 128 + d);
            const float y0 = a0.x + a1.x, y1 = a0.y + a1.y; const float r = rsqrtf(wave_sum(y0 * y0 + y1 * y1) * (1.f / 128.f) + 1e-6f);
            const u32 gt = *(const u32*)(PAB + (size_t)m * PAB_LD + CB_R + h * 128 + d);
            const float o0 = y0 * r * p.ab_head_g[128 + d] * siluf(__uint_as_float(gt << 16)), o1 = y1 * r * p.ab_head_g[128 + d + 1] * siluf(__uint_as_float(gt & 0xffff0000u));
            *(u32*)(YM + (size_t)m * DM + 1024 + h * 128 + d) = pk2(o0, o1); }
    }
}

__device__ __forceinline__ u32 ord_key(float s) { const u32 u = __float_as_uint(s); return (u & 0x80000000u) ? ~u : (u | 0x80000000u); }
__device__ __forceinline__ float ord_val(u32 o) { const u32 u = (o & 0x80000000u) ? (o ^ 0x80000000u) : ~o; return __uint_as_float(u); }
__device__ void ph_route(const Params& p, int l, int nrows, unsigned char* smem) {
    const bf16_t* QP = (const bf16_t*)(p.ws + OFF_QP); int* EIDX = (int*)(p.ws + OFF_EIDX); float* EG = (float*)(p.ws + OFF_EG);
    const int lane = threadIdx.x & 63, wave = threadIdx.x >> 6;
    float* qsh = (float*)smem + wave * 256;
    for (int j = blockIdx.x * 8 + wave; j < nrows * 8; j += gridDim.x * 8) {
        const int m = j >> 3, head = j & 7;
        {   const u32x2 qq = *(const u32x2*)(QP + (size_t)m * DM + head * 256 + lane * 4);
            qsh[lane * 4 + 0] = __uint_as_float(qq.x << 16); qsh[lane * 4 + 1] = __uint_as_float(qq.x & 0xffff0000u);
            qsh[lane * 4 + 2] = __uint_as_float(qq.y << 16); qsh[lane * 4 + 3] = __uint_as_float(qq.y & 0xffff0000u); }
        __builtin_amdgcn_wave_barrier();
        u32 selk[2];
#pragma unroll
        for (int z = 0; z < 2; ++z) {
            const float* keys = p.peer_sub_keys + ((size_t)((l * 8 + head) * 2 + z) * 128) * 128;
            float s0 = 0.f, s1 = 0.f;
            const f32x4* r0 = (const f32x4*)(keys + (size_t)lane * 128); const f32x4* r1 = (const f32x4*)(keys + (size_t)(lane + 64) * 128);
            const f32x4* q4 = (const f32x4*)(qsh + z * 128);
#pragma unroll 8
            for (int d = 0; d < 32; ++d) { const f32x4 q = q4[d], a = r0[d], b = r1[d]; s0 += q.x * a.x + q.y * a.y + q.z * a.z + q.w * a.w; s1 += q.x * b.x + q.y * b.y + q.z * b.z + q.w * b.w; }
            u32 k0 = (ord_key(s0) & ~0x7fu) | (u32)(127 - lane), k1 = (ord_key(s1) & ~0x7fu) | (u32)(127 - (lane + 64));
            u32 sel = 0u;
            for (int r = 0; r < 16; ++r) { u32 b = k0 > k1 ? k0 : k1; b = wave_max_u32(b); if (k0 == b) k0 = 0u; if (k1 == b) k1 = 0u; if (lane == r) sel = b; }
            selk[z] = sel;
        }
        const float v1 = ord_val(selk[0] & ~0x7fu), v2 = ord_val(selk[1] & ~0x7fu);
        const int i1 = 127 - (int)(selk[0] & 0x7fu), i2 = 127 - (int)(selk[1] & 0x7fu);
        const float sa = __shfl(v1, lane >> 2);
        u32 ck[4];
#pragma unroll
        for (int jj = 0; jj < 4; ++jj) { const float sb = __shfl(v2, (lane & 3) * 4 + jj); ck[jj] = (ord_key(sa + sb) & ~0xffu) | (u32)(255 - (lane * 4 + jj)); }
        u32 sel = 0u;
        for (int r = 0; r < 16; ++r) {
            u32 b = ck[0] > ck[1] ? ck[0] : ck[1]; const u32 b2 = ck[2] > ck[3] ? ck[2] : ck[3]; b = b > b2 ? b : b2; b = wave_max_u32(b);
#pragma unroll
            for (int jj = 0; jj < 4; ++jj) if (ck[jj] == b) ck[jj] = 0u;
            if (lane == r) sel = b;
        }
        const int cj = 255 - (int)(sel & 0xffu);
        const int ia = __shfl(i1, (cj >> 4) & 15), ib = __shfl(i2, cj & 15);
        const float bv = ord_val(sel & ~0xffu);
        const float top = __shfl(bv, 0);
        const float ex = lane < 16 ? __expf(bv - top) : 0.f;
        const float sum = wave_sum(ex);
        if (lane < 16) { EIDX[(size_t)m * 128 + head * 16 + lane] = ia * 128 + ib; EG[(size_t)m * 128 + head * 16 + lane] = ex / sum; }
        __builtin_amdgcn_wave_barrier();
    }
}

__device__ void ph_experts(const Params& p, int l, int nrows, float* x_lat, float* x_ctx, unsigned char* smem) {
    const bf16_t* H = (const bf16_t*)(p.ws + OFF_H); const int* EIDX = (const int*)(p.ws + OFF_EIDX); const float* EG = (const float*)(p.ws + OFF_EG);
    const bf16_t* TU = (const bf16_t*)(p.ws + (l == 0 ? OFF_TU0 : OFF_TU1)); const bf16_t* TV = (const bf16_t*)(p.ws + (l == 0 ? OFF_TV0 : OFF_TV1));
    const float* modv = (const float*)(p.ws + OFF_MODV);
    float* part = (float*)smem;
    const int tid = threadIdx.x, lane = tid & 63, wave = tid >> 6;
    for (int m = blockIdx.x; m < nrows; m += gridDim.x) {
        float hr[4][8];
#pragma unroll
        for (int j = 0; j < 4; ++j) { const u32x4 w = *(const u32x4*)(H + (size_t)m * DM + j * 512 + lane * 8);
            hr[j][0] = __uint_as_float(w.x << 16); hr[j][1] = __uint_as_float(w.x & 0xffff0000u); hr[j][2] = __uint_as_float(w.y << 16); hr[j][3] = __uint_as_float(w.y & 0xffff0000u);
            hr[j][4] = __uint_as_float(w.z << 16); hr[j][5] = __uint_as_float(w.z & 0xffff0000u); hr[j][6] = __uint_as_float(w.w << 16); hr[j][7] = __uint_as_float(w.w & 0xffff0000u); }
        float acc[4][8];
#pragma unroll
        for (int j = 0; j < 4; ++j)
#pragma unroll
            for (int e = 0; e < 8; ++e) acc[j][e] = 0.f;
        for (int r = 0; r < 16; ++r) {
            const int e = EIDX[(size_t)m * 128 + wave * 16 + r]; const float g = EG[(size_t)m * 128 + wave * 16 + r];
            const bf16_t* ur = TU + (size_t)e * DM; const bf16_t* vr = TV + (size_t)e * DM;
            u32x4 uw[4], vw[4];
#pragma unroll
            for (int j = 0; j < 4; ++j) { uw[j] = *(const u32x4*)(ur + j * 512 + lane * 8); vw[j] = *(const u32x4*)(vr + j * 512 + lane * 8); }
            float dot = 0.f;
#pragma unroll
            for (int j = 0; j < 4; ++j) {
                dot += hr[j][0] * __uint_as_float(uw[j].x << 16) + hr[j][1] * __uint_as_float(uw[j].x & 0xffff0000u) + hr[j][2] * __uint_as_float(uw[j].y << 16) + hr[j][3] * __uint_as_float(uw[j].y & 0xffff0000u)
                     + hr[j][4] * __uint_as_float(uw[j].z << 16) + hr[j][5] * __uint_as_float(uw[j].z & 0xffff0000u) + hr[j][6] * __uint_as_float(uw[j].w << 16) + hr[j][7] * __uint_as_float(uw[j].w & 0xffff0000u); }
            dot = wave_sum(dot);
            const float w = g * gelu_tanh(dot);
#pragma unroll
            for (int j = 0; j < 4; ++j) {
                acc[j][0] += w * __uint_as_float(vw[j].x << 16); acc[j][1] += w * __uint_as_float(vw[j].x & 0xffff0000u); acc[j][2] += w * __uint_as_float(vw[j].y << 16); acc[j][3] += w * __uint_as_float(vw[j].y & 0xffff0000u);
                acc[j][4] += w * __uint_as_float(vw[j].z << 16); acc[j][5] += w * __uint_as_float(vw[j].z & 0xffff0000u); acc[j][6] += w * __uint_as_float(vw[j].w << 16); acc[j][7] += w * __uint_as_float(vw[j].w & 0xffff0000u); }
        }
#pragma unroll
        for (int j = 0; j < 4; ++j) { float* d = part + wave * 2048 + j * 512 + lane * 8;
            *(f32x4*)d = (f32x4){acc[j][0], acc[j][1], acc[j][2], acc[j][3]}; *(f32x4*)(d + 4) = (f32x4){acc[j][4], acc[j][5], acc[j][6], acc[j][7]}; }
        __syncthreads();
        {   f32x4 s = {0.f, 0.f, 0.f, 0.f};
#pragma unroll
            for (int w = 0; w < 8; ++w) s += *(const f32x4*)(part + w * 2048 + tid * 4);
            const bool isc = m >= NL; float* xr = isc ? x_ctx + (size_t)(m - NL) * DM : x_lat + (size_t)m * DM;
            const f32x4 gate = *(const f32x4*)(modv + (size_t)(l * 2 + (isc ? 1 : 0)) * 12288 + 5 * 2048 + tid * 4);
            f32x4 xv = *(const f32x4*)(xr + tid * 4); xv += gate * s; *(f32x4*)(xr + tid * 4) = xv; }
        __syncthreads();
    }
}

__device__ void ph_prep_cd(const Params& p) {
    const bf16_t* PCD = (const bf16_t*)(p.ws + OFF_PAB);
    bf16_t* CQ = (bf16_t*)(p.ws + OFF_CQ); bf16_t* CK = (bf16_t*)(p.ws + OFF_CK); bf16_t* DQ = (bf16_t*)(p.ws + OFF_DQ); bf16_t* DK = (bf16_t*)(p.ws + OFF_DK);
    const int lane = threadIdx.x & 63, wave = threadIdx.x >> 6;
    const int d0 = (lane & 31) + 64 * (lane >> 5), d1 = d0 + 32;
    const float freq = __powf(10000.f, -(float)(lane & 31) * (1.f / 32.f));
    for (int j = blockIdx.x * 8 + wave; j < NT * 26; j += gridDim.x * 8) {
        const int m = j / 26, s = j % 26;
        if (m >= NL && (s < 8 || (s >= 16 && s < 24))) continue;
        int col, gi; bool rope; float scale; bf16_t* dst;
        if (s < 8) { col = 2560 + s * 128; gi = 0; rope = false; scale = 0.08838834764831845f; dst = CQ + ((size_t)s * NL + m) * 128; }
        else if (s < 16) { col = (s - 8) * 128; gi = 1; rope = false; scale = 1.f; dst = CK + ((size_t)(s - 8) * NT + m) * 128; }
        else if (s < 24) { col = 3584 + (s - 16) * 128; gi = 2; rope = true; scale = 0.08838834764831845f; dst = DQ + ((size_t)(s - 16) * NL + m) * 128; }
        else { col = 2048 + (s - 24) * 128; gi = 3; rope = m < NL; scale = 1.f; dst = DK + ((size_t)(s - 24) * NT + m) * 128; }
        const bf16_t* src = PCD + (size_t)m * PCD_LD + col;
        float x0 = bf2f(src[d0]), x1 = bf2f(src[d1]);
        const float r = rsqrtf(wave_sum(x0 * x0 + x1 * x1) * (1.f / 128.f) + 1e-6f);
        x0 *= r * p.cd_qk_g[gi * 128 + d0]; x1 *= r * p.cd_qk_g[gi * 128 + d1];
        if (rope) { const float pos = (float)((lane < 32) ? (m >> 6) : (m & 63)); const float ang = pos * freq; const float cs = cosf(ang), sn = sinf(ang);
            const float y0 = x0 * cs - x1 * sn, y1 = x0 * sn + x1 * cs; x0 = y0; x1 = y1; }
        dst[d0] = (bf16_t)f2bf(x0 * scale); dst[d1] = (bf16_t)f2bf(x1 * scale);
    }
}

__device__ void ph_attn_naive(const Params& p, unsigned char* smem) {
    const bf16_t* PCD = (const bf16_t*)(p.ws + OFF_PAB);
    const bf16_t* CQ = (const bf16_t*)(p.ws + OFF_CQ); const bf16_t* CK = (const bf16_t*)(p.ws + OFF_CK); const bf16_t* DQ = (const bf16_t*)(p.ws + OFF_DQ); const bf16_t* DK = (const bf16_t*)(p.ws + OFF_DK);
    bf16_t* YM = (bf16_t*)(p.ws + OFF_YM);
    const int lane = threadIdx.x & 63, wave = threadIdx.x >> 6;
    float* qsh = (float*)smem + wave * 128;
    for (int j = blockIdx.x * 8 + wave; j < NL * 16; j += gridDim.x * 8) {
        const int m = j >> 4, hh = j & 15; const bool isC = hh < 8; const int h = hh & 7; const int kvh = h >> 2;
        const bf16_t* qrow = isC ? CQ + ((size_t)h * NL + m) * 128 : DQ + ((size_t)h * NL + m) * 128;
        qsh[lane] = bf2f(qrow[lane]); qsh[lane + 64] = bf2f(qrow[lane + 64]);
        __builtin_amdgcn_wave_barrier();
        const bf16_t* Kb = isC ? CK + (size_t)h * NT * 128 : DK + (size_t)kvh * NT * 128;
        const int vcol = isC ? 1024 + h * 128 : 2304 + kvh * 128;
        const int r = m >> 6, c = m & 63; const int rs = min(max(r - 4, 0), 120), cs = min(max(c - 8, 0), 48); const int tb = m >> 6;
        float mx = -INFINITY, lsum = 0.f, a0 = 0.f, a1 = 0.f;
        const int nblk = isC ? 12 : 9;
        for (int b = 0; b < nblk; ++b) {
            int key; bool valid; float bias = 0.f;
            if (isC) { if (b < 8) { key = (rs + b) * 64 + lane; valid = lane >= cs && lane < cs + 16; if (valid) bias = p.cd_rpb[(h * 15 + (rs + b - r + 7)) * 31 + (lane - c + 15)]; } else { key = NL + (b - 8) * 64 + lane; valid = true; } }
            else { if (b < 5) { const int kb = tb - 2 + b; key = kb * 64 + lane; valid = kb >= 0 && kb < 128 && abs(key - m) <= 128; if (kb < 0 || kb >= 128) key = 0; } else { key = NL + (b - 5) * 64 + lane; valid = true; } }
            const bf16_t* krow = Kb + (size_t)key * 128;
            float s = 0.f;
#pragma unroll
            for (int c8 = 0; c8 < 16; ++c8) { const u32x4 kk = *(const u32x4*)(krow + c8 * 8); const f32x4 q0 = *(const f32x4*)(qsh + c8 * 8), q1 = *(const f32x4*)(qsh + c8 * 8 + 4);
                s += q0.x * __uint_as_float(kk.x << 16) + q0.y * __uint_as_float(kk.x & 0xffff0000u) + q0.z * __uint_as_float(kk.y << 16) + q0.w * __uint_as_float(kk.y & 0xffff0000u)
                   + q1.x * __uint_as_float(kk.z << 16) + q1.y * __uint_as_float(kk.z & 0xffff0000u) + q1.z * __uint_as_float(kk.w << 16) + q1.w * __uint_as_float(kk.w & 0xffff0000u); }
            s = valid ? s + bias : -INFINITY;
            const float bm = wave_max(s);
            if (bm == -INFINITY) continue;
            const float mn = fmaxf(mx, bm); const float corr = __expf(mx - mn); const float pj = valid ? __expf(s - mn) : 0.f;
            lsum = lsum * corr + wave_sum(pj); a0 *= corr; a1 *= corr; mx = mn;
            for (int t = 0; t < 64; ++t) {
                const float pt = __shfl(pj, t); const int kt = __shfl(key, t);
                if (pt != 0.f) { const bf16_t* vrow = PCD + (size_t)kt * PCD_LD + vcol; a0 += pt * bf2f(vrow[lane]); a1 += pt * bf2f(vrow[lane + 64]); }
            }
        }
        if (!isC) lsum += __expf(p.cd_sink[h] - mx);
        const float inv = 1.f / lsum;
        YM[(size_t)m * DM + hh * 128 + lane] = (bf16_t)f2bf(a0 * inv); YM[(size_t)m * DM + hh * 128 + lane + 64] = (bf16_t)f2bf(a1 * inv);
        __builtin_amdgcn_wave_barrier();
    }
}

enum { P_MOD = 0, P_TABLES, P_NORM_L0A, P_GEMM_AB, P_PREP_AB, P_MLSTM, P_GLA, P_MERGE_AB, P_GEMM_OUT0, P_NORM_L0B, P_GEMM_Q0, P_ROUTE0, P_EXPERTS0,
       P_NORM_L1A, P_GEMM_CD, P_PREP_CD, P_ATTN, P_GEMM_OUT1, P_NORM_L1B, P_GEMM_Q1, P_ROUTE1, P_EXPERTS1, P_COUNT };

template <int PH>
__global__ void __launch_bounds__(NTHR) k_phase(Params p) {
    extern __shared__ __attribute__((aligned(16))) unsigned char smem[];
    const float* modv = (const float*)(p.ws + OFF_MODV);
    float* XC = (float*)(p.ws + OFF_XC);
    bf16_t* H = (bf16_t*)(p.ws + OFF_H); bf16_t* YM = (bf16_t*)(p.ws + OFF_YM); bf16_t* QP = (bf16_t*)(p.ws + OFF_QP); bf16_t* PAB = (bf16_t*)(p.ws + OFF_PAB);
    if constexpr (PH == P_MOD) ph_mod(p, smem);
    if constexpr (PH == P_TABLES) ph_conv_tables(p);
    if constexpr (PH == P_NORM_L0A) ph_norm(p, 0, 0, p.x, p.ctx, NT);
    if constexpr (PH == P_GEMM_AB) { EpiStoreBf16 E{PAB, PAB_LD}; ph_gemm_naive(H, p.ab_w_in, NT, 7232, E, smem); }
    if constexpr (PH == P_PREP_AB) ph_prep_ab(p, smem);
    if constexpr (PH == P_MLSTM) ph_mlstm_naive(p, smem);
    if constexpr (PH == P_GLA) ph_gla_naive(p, smem);
    if constexpr (PH == P_MERGE_AB) ph_merge_ab(p);
    if constexpr (PH == P_GEMM_OUT0) { EpiResidual E{p.x, p.ctx, p.out, XC, modv + 2 * 2048, modv + 12288 + 2 * 2048}; ph_gemm_naive(YM, p.ab_w_out, NT, 2048, E, smem); }
    if constexpr (PH == P_NORM_L0B) ph_norm(p, 0, 1, p.out, XC, NT);
    if constexpr (PH == P_GEMM_Q0) { EpiStoreBf16 E{QP, DM}; ph_gemm_naive(H, p.peer_w_q, NT, 2048, E, smem); }
    if constexpr (PH == P_ROUTE0) ph_route(p, 0, NT, smem);
    if constexpr (PH == P_EXPERTS0) ph_experts(p, 0, NT, p.out, XC, smem);
    if constexpr (PH == P_NORM_L1A) ph_norm(p, 1, 0, p.out, XC, NT);
    if constexpr (PH == P_GEMM_CD) { EpiStoreBf16 E{PAB, PCD_LD}; ph_gemm_naive(H, p.cd_w_in, NT, 4608, E, smem); }
    if constexpr (PH == P_PREP_CD) ph_prep_cd(p);
    if constexpr (PH == P_ATTN) ph_attn_naive(p, smem);
    if constexpr (PH == P_GEMM_OUT1) { EpiResidual E{p.out, XC, p.out, XC, modv + 2 * 12288 + 2 * 2048, modv + 3 * 12288 + 2 * 2048}; ph_gemm_naive(YM, p.cd_w_out, NL, 2048, E, smem); }
    if constexpr (PH == P_NORM_L1B) ph_norm(p, 1, 1, p.out, XC, NL);
    if constexpr (PH == P_GEMM_Q1) { EpiStoreBf16 E{QP, DM}; ph_gemm_naive(H, p.peer_w_q + (size_t)2048 * 2048, NL, 2048, E, smem); }
    if constexpr (PH == P_ROUTE1) ph_route(p, 1, NL, smem);
    if constexpr (PH == P_EXPERTS1) ph_experts(p, 1, NL, p.out, XC, smem);
}

#ifndef LAST_PHASE
#define LAST_PHASE (P_COUNT - 1)
#endif

template <int PH> static void launch_phase(const Params& p, int grid, hipStream_t stream) {
    hipLaunchKernelGGL(k_phase<PH>, dim3(grid), dim3(NTHR), 65536, stream, p);
}
template <int PH> static void launch_upto(const Params& p, hipStream_t stream) {
    if constexpr (PH > 0) launch_upto<PH - 1>(p, stream);
    int grid = 1024;
    if (PH == P_MLSTM || PH == P_GLA) grid = 16;
    if (PH == P_EXPERTS0 || PH == P_EXPERTS1) grid = 2048;
    if (PH <= LAST_PHASE) launch_phase<PH>(p, grid, stream);
}

extern "C" void kernel_launch(void* const* d_in, const int* in_sizes, int n_in, void* d_out, int out_size, void* d_ws, size_t ws_size, hipStream_t stream) {
    Params p{};
    const float** pp = (const float**)&p;
    for (int i = 0; i < 24; ++i) pp[i] = (const float*)d_in[i];
    p.out = (float*)d_out; p.ws = (unsigned char*)d_ws;
    hipMemsetAsync((char*)d_ws + OFF_CTL, 0, CTL_BYTES, stream);
#if LAST_PHASE < P_GEMM_OUT0
    hipMemcpyAsync(d_out, d_in[0], (size_t)NL * DM * 4, hipMemcpyDeviceToDevice, stream);
#endif
    launch_upto<P_COUNT - 1>(p, stream);
}
```

```cpp
#include <hip/hip_runtime.h>
#include <hip/hip_cooperative_groups.h>
namespace cg = cooperative_groups;
#include <cstdint>
#include <cstdio>

typedef unsigned short bf16_t;
typedef unsigned int u32;
typedef float f32x4 __attribute__((ext_vector_type(4)));
typedef unsigned u32x4 __attribute__((ext_vector_type(4)));
typedef unsigned u32x2 __attribute__((ext_vector_type(2)));

constexpr int NL = 8192, NC = 256, NT = 8448, DM = 2048;
constexpr int PAB_LD = 7424, PCD_LD = 4608;
constexpr int NTHR = 512;
constexpr int CA_Q = 0, CA_K = 1024, CA_V = 2048, CA_O = 3072, CA_G = 4096, CB_Q = 4128, CB_K = 4640, CB_V = 5152, CB_R = 6176, CB_LR = 7200;

constexpr size_t MiB = 1u << 20;
constexpr size_t OFF_CTL = 0, CTL_BYTES = 1 * MiB;
constexpr size_t OFF_MODV = 64 * 1024;
constexpr size_t OFF_H = 2 * MiB;
constexpr size_t OFF_YM = 36 * MiB;
constexpr size_t OFF_QP = 70 * MiB;
constexpr size_t OFF_XC = 104 * MiB;
constexpr size_t OFF_EIDX = 106 * MiB;
constexpr size_t OFF_EG = 111 * MiB;
constexpr size_t OFF_PAB = 116 * MiB;
constexpr size_t OFF_AQ = 236 * MiB;
constexpr size_t OFF_AK = 253 * MiB;
constexpr size_t OFF_AKT = 270 * MiB;
constexpr size_t OFF_AVT = 287 * MiB;
constexpr size_t OFF_IG = 306 * MiB;
constexpr size_t OFF_LF = 307 * MiB;
constexpr size_t OFF_BQS = 308 * MiB;
constexpr size_t OFF_BKS = 325 * MiB;
constexpr size_t OFF_BKENDT = 342 * MiB;
constexpr size_t OFF_BVT = 359 * MiB;
constexpr size_t OFF_GDEC = 376 * MiB;
constexpr size_t OFF_DEC = 376 * MiB + 768 * 1024;
constexpr size_t OFF_HQ = 380 * MiB;
constexpr size_t OFF_HQS = 397 * MiB;
constexpr size_t OFF_KEYSB = 378 * MiB;
constexpr size_t OFF_TS = 377 * MiB;
constexpr size_t OFF_DCT = 410 * MiB;
constexpr size_t OFF_DST = 485 * MiB;
constexpr size_t OFF_TU0 = 592 * MiB, OFF_TV0 = 656 * MiB, OFF_TU1 = 720 * MiB, OFF_TV1 = 784 * MiB;
constexpr size_t OFF_WT_AB = 848 * MiB, OFF_WT_ABOUT = 877 * MiB, OFF_WT_CD = 885 * MiB, OFF_WT_CDOUT = 903 * MiB, OFF_WT_PQ0 = 911 * MiB, OFF_WT_PQ1 = 919 * MiB;
constexpr size_t OFF_SCR = 928 * MiB;
constexpr size_t OFF_H8 = 692 * MiB;
constexpr size_t OFF_HS8 = 397 * MiB + 64 * 1024;
constexpr size_t OFF_WSC = 397 * MiB + 128 * 1024;
constexpr size_t OFF_CMAX = 256 * 1024;
constexpr size_t OFF_CQ = 236 * MiB;
constexpr size_t OFF_CK = 253 * MiB;
constexpr size_t OFF_DQ = 287 * MiB;
constexpr size_t OFF_DK = 308 * MiB;
constexpr size_t OFF_CVT = 270 * MiB;
constexpr size_t OFF_DVT = 313 * MiB;

struct Params {
    const float *x, *c, *ctx, *c_ctx, *mod_w, *mod_b, *norm_g, *ab_w_in, *ab_conv_w, *ab_conv_b, *ab_gate_b, *ab_alpha_w2,
        *ab_alpha_b, *ab_head_g, *ab_w_out, *cd_w_in, *cd_qk_g, *cd_rpb, *cd_sink, *cd_w_out, *peer_w_q, *peer_sub_keys, *peer_u, *peer_v;
    float* out; unsigned char* ws;
};

__device__ __forceinline__ int TID() { int t = (int)__builtin_amdgcn_workitem_id_x(); asm volatile("" : "+v"(t)); return t; }
__device__ __forceinline__ float bf2f(bf16_t v) { return __uint_as_float(((u32)v) << 16); }
typedef float f32x2v_t __attribute__((ext_vector_type(2)));
typedef __bf16 bf16x2v_t __attribute__((ext_vector_type(2)));
__device__ __forceinline__ u32 pk2(float lo, float hi) { const f32x2v_t v = {lo, hi}; const bf16x2v_t b = __builtin_convertvector(v, bf16x2v_t); return __builtin_bit_cast(unsigned, b); }
__device__ __forceinline__ u32 f2bf(float f) { return pk2(f, 0.f) & 0xffffu; }
__device__ __forceinline__ float bfl(u32 w) { return __uint_as_float(w << 16); }
__device__ __forceinline__ float bfh(u32 w) { return __uint_as_float(w & 0xffff0000u); }
__device__ __forceinline__ float wave_sum(float v) {
#pragma unroll
    for (int o = 1; o < 64; o <<= 1) v += __shfl_xor(v, o);
    return v;
}
__device__ __forceinline__ float wave_max(float v) {
#pragma unroll
    for (int o = 1; o < 64; o <<= 1) v = fmaxf(v, __shfl_xor(v, o));
    return v;
}
__device__ __forceinline__ u32 wave_max_u32(u32 v) {
#pragma unroll
    for (int o = 1; o < 64; o <<= 1) { u32 t = (u32)__shfl_xor((int)v, o); v = t > v ? t : v; }
    return v;
}
__device__ __forceinline__ float frcp(float a) { return __builtin_amdgcn_rcpf(a); }
__device__ __forceinline__ float siluf(float a) { return a * frcp(1.f + __expf(-a)); }
__device__ __forceinline__ float sigmoidf_(float a) { return frcp(1.f + __expf(-a)); }
__device__ __forceinline__ float logsigf(float a) { return a < 0.f ? a - log1pf(__expf(a)) : -log1pf(__expf(-a)); }
__device__ __forceinline__ float gelu_tanh(float v) { return 0.5f * v * (1.f + tanhf(0.7978845608028654f * (v + 0.044715f * v * v * v))); }

namespace pg8 {
#define PG8_LAS __attribute__((address_space(3)))
typedef unsigned short bf16_t;
typedef short bf16x8 __attribute__((ext_vector_type(8)));
typedef float f32x4 __attribute__((ext_vector_type(4)));
typedef unsigned u32x4 __attribute__((ext_vector_type(4)));
typedef int i32x4_t __attribute__((ext_vector_type(4)));
constexpr int BM = 256, BK = 64, HALF = 128, HTB = HALF * BK * 2  , STAGE_BYTES = 8 * HTB, NXCD = 8, WGM = 8;

__host__ __device__ __forceinline__ int lds_byte(int r, int c) { const int st = (r >> 4) * 2 + (c >> 5), rr = r & 15, cc = c & 31, ob = rr * 64 + cc * 2; return st * 1024 + (ob ^ (((ob >> 9) & 1) << 5)); }
__host__ __device__ __forceinline__ void stage_rc(int b, int& R, int& C) { const int st = b / 1024, sb = b % 1024, swz = sb ^ (((sb >> 9) & 1) << 5); R = (st >> 1) * 16 + swz / 64; C = (st & 1) * 32 + (swz % 64) / 2; }
__host__ __device__ __forceinline__ int perm32(int rho) { const int n = rho >> 4, i = rho & 15; return 8 * (i >> 2) + 4 * n + (i & 3); }

struct Unit { int pm, pn; };
struct Gemm { const bf16_t* A; const bf16_t* Bt; int M, N, K; };

struct StaticOrder {
    int nM, nN, nwg, G, c;
    __host__ __device__ void init(int M, int N, int G_, int c_) { nM = M / BM; nN = N / BM; nwg = nM * nN; G = G_; c = c_; }
    __host__ __device__ bool next(int i, Unit& u) const {
        const long L = (long)i * G + c; if (L >= nwg) return false;
        int wgid = (int)L; { const int q = nwg / NXCD, r = nwg % NXCD, xcd = wgid % NXCD, off = wgid / NXCD; wgid = (xcd < r ? xcd * (q + 1) : r * (q + 1) + (xcd - r) * q) + off; }
        const int nig = WGM * nN, gid = wgid / nig, fm = gid * WGM, gsz = (nM - fm) < WGM ? (nM - fm) : WGM;
        u.pm = fm + ((wgid % nig) % gsz); u.pn = (wgid % nig) / gsz; return true;
    }
    __device__ __forceinline__ void a_ready(const Unit&) const {}
    __device__ __forceinline__ void done(const Unit&) const {}
};

__device__ __forceinline__ unsigned cvt_pk_bf16(float lo, float hi) { unsigned r; asm volatile("v_cvt_pk_bf16_f32 %0, %1, %2" : "=v"(r) : "v"(lo), "v"(hi)); return r; }
typedef float f32x2 __attribute__((ext_vector_type(2)));
__device__ __forceinline__ f32x2 gelu_pk(f32x2 v) {
    const f32x2 av = __builtin_elementwise_abs(v), d = av * 0.2316418882f + 1.0f;
    f32x2 t; t.x = __builtin_amdgcn_rcpf(d.x); t.y = __builtin_amdgcn_rcpf(d.y);
    f32x2 q = t * 0.5307027145f + (-0.7265760135f); q = q * t + 0.7107068705f; q = q * t + (-0.142248368f); q = q * t + 0.127414796f; q = q * t;
    const f32x2 s = (v * v) * (-0.72134752044f);
    f32x2 e; e.x = __builtin_amdgcn_exp2f(s.x); e.y = __builtin_amdgcn_exp2f(s.y);
    const f32x2 m = v * (q * e), r = v - m;
    f32x2 o; o.x = v.x < 0.f ? m.x : r.x; o.y = v.y < 0.f ? m.y : r.y; return o;
}

template <int ACT  > struct EpiBf16 {
    static constexpr bool PERM = true, AFTER_DRAIN = false; static_assert(ACT == 0 || ACT == 1, "EpiBf16: ACT is 0 (none) or 1 (gelu_pk)");
    bf16_t* O; int ldc; const float* bias; int split_cols; size_t split_stride; float scale0;
    __device__ __forceinline__ void operator()(const f32x4 (&acc)[2][2][4][2], const Unit& u, int wr, int wc, int fr, int fq) const {
        const int row0 = u.pm * BM + wr * 64 + fr; int colt = u.pn * BM; bf16_t* base = O;
        float sc = 1.f; if (split_cols) { const int t = colt / split_cols; base += (size_t)t * split_stride; colt -= t * split_cols; if (t == 0) sc = scale0; }
        const int col0 = colt + wc * 32 + 8 * fq, bcol0 = u.pn * BM + wc * 32 + 8 * fq;
        f32x4 bv[2][2];
#pragma unroll
        for (int bj = 0; bj < 2; ++bj)
#pragma unroll
            for (int n = 0; n < 2; ++n) bv[bj][n] = bias ? *(const f32x4*)(bias + bcol0 + bj * HALF + 4 * n) : (f32x4){0.f, 0.f, 0.f, 0.f};
#pragma unroll
        for (int ai = 0; ai < 2; ++ai)
#pragma unroll
            for (int m = 0; m < 4; ++m) { bf16_t* rowp = base + (size_t)(row0 + ai * HALF + m * 16) * ldc + col0;
#pragma unroll
                for (int bj = 0; bj < 2; ++bj) { f32x4 v0 = acc[ai][bj][m][0] + bv[bj][0], v1 = acc[ai][bj][m][1] + bv[bj][1];
                    if (ACT == 1) { f32x2 a = gelu_pk((f32x2){v0[0], v0[1]}), b = gelu_pk((f32x2){v0[2], v0[3]}), c = gelu_pk((f32x2){v1[0], v1[1]}), d = gelu_pk((f32x2){v1[2], v1[3]});
                        v0 = (f32x4){a.x, a.y, b.x, b.y}; v1 = (f32x4){c.x, c.y, d.x, d.y}; }
                    v0 = v0 * sc; v1 = v1 * sc; u32x4 w; w.x = cvt_pk_bf16(v0[0], v0[1]); w.y = cvt_pk_bf16(v0[2], v0[3]); w.z = cvt_pk_bf16(v1[0], v1[1]); w.w = cvt_pk_bf16(v1[2], v1[3]);
                    *(u32x4*)(rowp + bj * HALF) = w; } }
    }
};

struct EpiI8 {
    static constexpr bool PERM = true, AFTER_DRAIN = false;
    bf16_t* O; int ldc; const float* srow; const float* scol;
    __device__ __forceinline__ void operator()(const f32x4 (&acc)[2][2][4][2], const Unit& u, int wr, int wc, int fr, int fq) const {
        const int row0 = u.pm * BM + wr * 64 + fr; const int col0 = u.pn * BM + wc * 32 + 8 * fq;
        f32x4 cs[2][2];
#pragma unroll
        for (int bj = 0; bj < 2; ++bj)
#pragma unroll
            for (int n = 0; n < 2; ++n) cs[bj][n] = *(const f32x4*)(scol + col0 + bj * HALF + 4 * n);
#pragma unroll
        for (int ai = 0; ai < 2; ++ai)
#pragma unroll
            for (int m = 0; m < 4; ++m) { const int row = row0 + ai * HALF + m * 16; const float sr = srow[row]; bf16_t* rowp = O + (size_t)row * ldc + col0;
#pragma unroll
                for (int bj = 0; bj < 2; ++bj) {
                    const i32x4_t a0 = __builtin_bit_cast(i32x4_t, acc[ai][bj][m][0]), a1 = __builtin_bit_cast(i32x4_t, acc[ai][bj][m][1]);
                    const f32x4 v0 = (f32x4){(float)a0[0], (float)a0[1], (float)a0[2], (float)a0[3]} * cs[bj][0] * sr, v1 = (f32x4){(float)a1[0], (float)a1[1], (float)a1[2], (float)a1[3]} * cs[bj][1] * sr;
                    u32x4 w; w.x = cvt_pk_bf16(v0[0], v0[1]); w.y = cvt_pk_bf16(v0[2], v0[3]); w.z = cvt_pk_bf16(v1[0], v1[1]); w.w = cvt_pk_bf16(v1[2], v1[3]);
                    *(u32x4*)(rowp + bj * HALF) = w; } }
    }
};
struct EpiResid {
    static constexpr bool PERM = false, AFTER_DRAIN = false;
    const float* xin_lat; const float* xin_ctx; float* xout_lat; float* xout_ctx; const float* gate_lat; const float* gate_ctx;
    __device__ __forceinline__ void operator()(const f32x4 (&acc)[2][2][4][2], const Unit& u, int wr, int wc, int fr, int fq) const {
        const bool isc = u.pm * BM >= 8192;
        const float* xin = isc ? xin_ctx - (size_t)8192 * 2048 : xin_lat; float* xout = isc ? xout_ctx - (size_t)8192 * 2048 : xout_lat; const float* gate = isc ? gate_ctx : gate_lat;
        const int row0 = u.pm * BM + wr * 64 + fr, col0 = u.pn * BM + wc * 32 + 4 * fq;
#pragma unroll
        for (int bj = 0; bj < 2; ++bj)
#pragma unroll
            for (int n = 0; n < 2; ++n) { const f32x4 g = *(const f32x4*)(gate + col0 + bj * HALF + n * 16);
#pragma unroll
                for (int ai = 0; ai < 2; ++ai) {
#pragma unroll
                    for (int m = 0; m < 4; ++m) { const size_t off = (size_t)(row0 + ai * HALF + m * 16) * 2048 + col0 + bj * HALF + n * 16;
                        const f32x4 b = *(const f32x4*)(xin + off); *(f32x4*)(xout + off) = b + g * acc[ai][bj][m][n]; }
                    asm volatile("" ::: "memory"); } }
    }
};
template <class Epi, class Sched, bool ALIGN_EPI = false, bool SP2 = false, bool I8 = false>
__device__ __forceinline__ void gemm_phase(PG8_LAS unsigned char* lds, const Gemm g, const Sched& S, const Epi& E) {
    const int tid = TID(), wid = __builtin_amdgcn_readfirstlane(tid >> 6), lane = tid & 63, wr = wid >> 2, wc = wid & 3, fr = lane & 15, fq = lane >> 4;
    const int K = g.K, nt = K / BK;
    unsigned voffA[2], voffB[2];
#pragma unroll
    for (int i = 0; i < 2; ++i) { int R, C; stage_rc(tid * 16 + i * 8192, R, C); const int Rb = Epi::PERM ? ((R & ~31) + perm32(R & 31)) : R;
        voffA[i] = (unsigned)(R * K + C) * 2u; voffB[i] = (unsigned)(Rb * K + C) * 2u; }
    const size_t kstep = (size_t)(BK * 2);
    const size_t hstep = (size_t)HALF * K * 2;
    const size_t tstep = 2 * hstep;
    const unsigned ldsw = (unsigned)wid * 1024u;
    const int aoff = lds_byte(wr * 64 + fr, fq * 8), boff = lds_byte(wc * 32 + fr, fq * 8);
#define PG8_SA(b, h) (((b) * 2 + (h)) * HTB)
#define PG8_SB(b, h) ((4 + (b) * 2 + (h)) * HTB)
#define PG8_STAGE(bufoff, gbase, voff) do { _Pragma("unroll") for (int _i = 0; _i < 2; ++_i) \
        __builtin_amdgcn_global_load_lds((const unsigned*)((const char*)(gbase) + (voff)[_i]), (PG8_LAS unsigned*)(lds + (bufoff) + ldsw + _i * 8192), 16, 0, 0); } while (0)
#define PG8_LDA(dst, b, h) do { _Pragma("unroll") for (int m = 0; m < 4; ++m) _Pragma("unroll") for (int k = 0; k < 2; ++k) dst[m][k] = *(const PG8_LAS bf16x8*)(lds + PG8_SA(b, h) + aoff + m * 2048 + k * 1024); } while (0)
#define PG8_LDB(dst, b, h) do { _Pragma("unroll") for (int n = 0; n < 2; ++n) _Pragma("unroll") for (int k = 0; k < 2; ++k) dst[n][k] = *(const PG8_LAS bf16x8*)(lds + PG8_SB(b, h) + boff + n * 2048 + k * 1024); } while (0)
#define PG8_MMA(ai, bj, At, Bt) do { __builtin_amdgcn_s_setprio(1); _Pragma("unroll") for (int m = 0; m < 4; ++m) _Pragma("unroll") for (int n = 0; n < 2; ++n) _Pragma("unroll") for (int k = 0; k < 2; ++k) \
        acc[ai][bj][m][n] = I8 ? __builtin_bit_cast(f32x4, __builtin_amdgcn_mfma_i32_16x16x64_i8(__builtin_bit_cast(i32x4_t, Bt[n][k]), __builtin_bit_cast(i32x4_t, At[m][k]), __builtin_bit_cast(i32x4_t, acc[ai][bj][m][n]), 0, 0, 0)) \
                                 : __builtin_amdgcn_mfma_f32_16x16x32_bf16(Bt[n][k], At[m][k], acc[ai][bj][m][n], 0, 0, 0); __builtin_amdgcn_s_setprio(0); } while (0)
#define PG8_WAIT_V(n) asm volatile("s_waitcnt vmcnt(" #n ")" ::: "memory")
#define PG8_WAIT_L(n) asm volatile("s_waitcnt lgkmcnt(" #n ")" ::: "memory")
#define PG8_BAR __builtin_amdgcn_s_barrier()
#define PG8_SCHED __builtin_amdgcn_sched_barrier(0)
    Unit cur, nxt; int ui = 0;
    if (!S.next(0, cur)) return;
    f32x4 acc[2][2][4][2];
#pragma unroll
    for (int a = 0; a < 2; ++a)
#pragma unroll
        for (int b = 0; b < 2; ++b)
#pragma unroll
            for (int m = 0; m < 4; ++m)
#pragma unroll
                for (int n = 0; n < 2; ++n) acc[a][b][m][n] = (f32x4){0.f, 0.f, 0.f, 0.f};
    bf16x8 At[4][2], B0[2][2], B1[2][2];
    const char* cA = (const char*)g.A + (size_t)cur.pm * tstep; const char* cB = (const char*)g.Bt + (size_t)cur.pn * tstep;
    S.a_ready(cur);
    if constexpr (SP2) {
        PG8_STAGE(PG8_SB(0, 0), cB, voffB); PG8_STAGE(PG8_SB(0, 1), cB + hstep, voffB); PG8_STAGE(PG8_SA(0, 0), cA, voffA); PG8_STAGE(PG8_SA(0, 1), cA + hstep, voffA);
        if (wr == 1) PG8_BAR;
        PG8_WAIT_V(2); PG8_BAR;
        PG8_STAGE(PG8_SB(1, 0), cB + kstep, voffB); PG8_STAGE(PG8_SA(1, 0), cA + kstep, voffA); PG8_STAGE(PG8_SB(1, 1), cB + hstep + kstep, voffB);
        PG8_WAIT_V(6); PG8_BAR;
    } else {
        PG8_STAGE(PG8_SB(0, 0), cB, voffB); PG8_STAGE(PG8_SA(0, 0), cA, voffA); PG8_STAGE(PG8_SB(0, 1), cB + hstep, voffB); PG8_STAGE(PG8_SA(0, 1), cA + hstep, voffA);
        if (wr == 1) PG8_BAR;
        PG8_WAIT_V(4); PG8_BAR;
        PG8_STAGE(PG8_SB(1, 0), cB + kstep, voffB); PG8_STAGE(PG8_SA(1, 0), cA + kstep, voffA); PG8_STAGE(PG8_SB(1, 1), cB + hstep + kstep, voffB);
        PG8_WAIT_V(6); PG8_BAR;
    }
    for (;;) {
        const bool has_next = S.next(ui + 1, nxt);
        const char* nA = has_next ? (const char*)g.A + (size_t)nxt.pm * tstep : cA; const char* nB = has_next ? (const char*)g.Bt + (size_t)nxt.pn * tstep : cB;
        for (int t = 0; t < nt; t += 2) {
            const bool last = (t == nt - 2);
            const char* a1 = cA + (size_t)(t + 1) * kstep;
            const char* a2 = last ? nA : cA + (size_t)(t + 2) * kstep; const char* b2 = last ? nB : cB + (size_t)(t + 2) * kstep;
            const char* a3 = a2 + kstep; const char* b3 = b2 + kstep;
            if (last && has_next) S.a_ready(nxt);
            if constexpr (SP2) {
            PG8_LDB(B0, 0, 0); PG8_LDB(B1, 0, 1); PG8_SCHED; PG8_LDA(At, 0, 0); PG8_STAGE(PG8_SA(1, 1), a1 + hstep, voffA);
            PG8_WAIT_V(8); PG8_WAIT_L(0); PG8_BAR; PG8_MMA(0, 0, At, B0); PG8_MMA(0, 1, At, B1); PG8_BAR; PG8_SCHED;
            PG8_LDA(At, 0, 1); PG8_STAGE(PG8_SB(0, 0), b2, voffB); PG8_STAGE(PG8_SB(0, 1), b2 + hstep, voffB); PG8_STAGE(PG8_SA(0, 0), a2, voffA);
            PG8_WAIT_V(8); PG8_WAIT_L(0); PG8_BAR; PG8_MMA(1, 0, At, B0); PG8_MMA(1, 1, At, B1); PG8_BAR; PG8_SCHED;
            PG8_LDB(B0, 1, 0); PG8_LDB(B1, 1, 1); PG8_SCHED; PG8_LDA(At, 1, 0); PG8_STAGE(PG8_SA(0, 1), a2 + hstep, voffA);
            PG8_WAIT_V(8); PG8_WAIT_L(0); PG8_BAR; PG8_MMA(0, 0, At, B0); PG8_MMA(0, 1, At, B1); PG8_BAR; PG8_SCHED;
            PG8_LDA(At, 1, 1); PG8_STAGE(PG8_SB(1, 0), b3, voffB); PG8_STAGE(PG8_SB(1, 1), b3 + hstep, voffB); PG8_STAGE(PG8_SA(1, 0), a3, voffA);
            PG8_WAIT_V(8); PG8_WAIT_L(0); PG8_BAR; PG8_MMA(1, 0, At, B0); PG8_MMA(1, 1, At, B1); PG8_BAR; PG8_SCHED;
            } else {
            PG8_LDB(B0, 0, 0); PG8_SCHED; PG8_LDA(At, 0, 0); PG8_STAGE(PG8_SA(1, 1), a1 + hstep, voffA);
            PG8_WAIT_L(8); PG8_BAR; PG8_WAIT_L(0); PG8_MMA(0, 0, At, B0); PG8_BAR; PG8_SCHED;
            PG8_LDB(B1, 0, 1); PG8_STAGE(PG8_SB(0, 0), b2, voffB);
            PG8_BAR; PG8_WAIT_L(0); PG8_MMA(0, 1, At, B1); PG8_BAR;
            PG8_LDA(At, 0, 1); PG8_STAGE(PG8_SA(0, 0), a2, voffA);
            PG8_BAR; PG8_WAIT_L(0); PG8_MMA(1, 0, At, B0); PG8_BAR; PG8_SCHED;
            PG8_STAGE(PG8_SB(0, 1), b2 + hstep, voffB);
            PG8_WAIT_V(6); PG8_BAR; PG8_MMA(1, 1, At, B1); PG8_BAR;
            PG8_LDB(B0, 1, 0); PG8_SCHED; PG8_LDA(At, 1, 0); PG8_STAGE(PG8_SA(0, 1), a2 + hstep, voffA);
            PG8_WAIT_L(8); PG8_BAR; PG8_WAIT_L(0); PG8_MMA(0, 0, At, B0); PG8_BAR; PG8_SCHED;
            PG8_LDB(B1, 1, 1); PG8_STAGE(PG8_SB(1, 0), b3, voffB);
            PG8_BAR; PG8_WAIT_L(0); PG8_MMA(0, 1, At, B1); PG8_BAR;
            PG8_LDA(At, 1, 1); PG8_STAGE(PG8_SA(1, 0), a3, voffA);
            PG8_BAR; PG8_WAIT_L(0); PG8_MMA(1, 0, At, B0); PG8_BAR; PG8_SCHED;
            PG8_STAGE(PG8_SB(1, 1), b3 + hstep, voffB);
            PG8_WAIT_V(6); PG8_BAR; PG8_MMA(1, 1, At, B1); PG8_BAR;
            }
        }
        if constexpr (ALIGN_EPI) { if (wr == 0) PG8_BAR; }
        if constexpr (!Epi::AFTER_DRAIN) { E(acc, cur, wr, wc, fr, fq); S.done(cur); }
        if (!has_next) break;
#pragma unroll
        for (int a = 0; a < 2; ++a)
#pragma unroll
            for (int b = 0; b < 2; ++b)
#pragma unroll
                for (int m = 0; m < 4; ++m)
#pragma unroll
                    for (int n = 0; n < 2; ++n) acc[a][b][m][n] = (f32x4){0.f, 0.f, 0.f, 0.f};
        cur = nxt; cA = nA; cB = nB; ++ui;
        if constexpr (ALIGN_EPI) { if (wr == 1) PG8_BAR; }
    }
    PG8_WAIT_V(0);
    if constexpr (!ALIGN_EPI) { if (wr == 0) PG8_BAR; }
    PG8_BAR;
    if constexpr (Epi::AFTER_DRAIN) { E.fused(acc, cur, wr, wc, fr, fq, lds, wid, lane); S.done(cur); }
#undef PG8_SA
#undef PG8_SB
#undef PG8_STAGE
#undef PG8_LDA
#undef PG8_LDB
#undef PG8_MMA
#undef PG8_WAIT_V
#undef PG8_WAIT_L
#undef PG8_BAR
#undef PG8_SCHED
}
}

#define LAS __attribute__((address_space(3)))
__device__ __forceinline__ void p0_transpose_item(const float* W, int K, int N, bf16_t* WT, LAS float* scr, int item, int lane) {
    const int nblk = N / 32, kb = item / nblk, nb = item % nblk, k0 = 64 * kb, n0 = 32 * nb;
#pragma unroll 8
    for (int i = 0; i < 32; ++i) { const int kk = 2 * i + (lane >> 5); scr[kk * 33 + (lane & 31)] = W[(size_t)(k0 + kk) * N + n0 + (lane & 31)]; }
    asm volatile("s_waitcnt lgkmcnt(0)" ::: "memory");
    const int c = lane & 7;
#pragma unroll
    for (int j = 0; j < 4; ++j) { const int n = (lane >> 3) + 8 * j; const LAS float* sp = scr + (8 * c) * 33 + n;
        u32x4 o; o.x = pk2(sp[0 * 33], sp[1 * 33]); o.y = pk2(sp[2 * 33], sp[3 * 33]); o.z = pk2(sp[4 * 33], sp[5 * 33]); o.w = pk2(sp[6 * 33], sp[7 * 33]);
        *(u32x4*)(WT + (size_t)(n0 + n) * K + k0 + 8 * c) = o; }
    asm volatile("s_waitcnt lgkmcnt(0)" ::: "memory");
}
__device__ __forceinline__ void ph_colmax(const Params& p) {
    unsigned* CM = (unsigned*)(p.ws + OFF_CTL + OFF_CMAX);
    constexpr int C_AB = 7232 / 4, C_CD = 4608 / 4, NIT = (C_AB + C_CD) * 16;
    for (int it = blockIdx.x * NTHR + TID(); it < NIT; it += gridDim.x * NTHR) {
        const int kc = it / (C_AB + C_CD), c = it % (C_AB + C_CD);
        const bool ab = c < C_AB; const int N = ab ? 7232 : 4608; const int c4 = ab ? c : c - C_AB;
        const f32x4* W = (const f32x4*)(ab ? p.ab_w_in : p.cd_w_in) + (size_t)(kc * 128) * (N / 4) + c4;
        f32x4 m = {0.f, 0.f, 0.f, 0.f};
#pragma unroll 8
        for (int k = 0; k < 128; ++k) { const f32x4 w = W[(size_t)k * (N / 4)]; m.x = fmaxf(m.x, fabsf(w.x)); m.y = fmaxf(m.y, fabsf(w.y)); m.z = fmaxf(m.z, fabsf(w.z)); m.w = fmaxf(m.w, fabsf(w.w)); }
        unsigned* o = CM + (ab ? 0 : 7424) + c4 * 4;
        atomicMax(o + 0, __float_as_uint(m.x)); atomicMax(o + 1, __float_as_uint(m.y)); atomicMax(o + 2, __float_as_uint(m.z)); atomicMax(o + 3, __float_as_uint(m.w));
    }
}
__device__ __forceinline__ void p0_transpose_item_i8(const float* W, int K, int N, unsigned char* WT, const unsigned* cmax, LAS float* scr, int item, int lane) {
    const int nblk = N / 32, kb = item / nblk, nb = item % nblk, k0 = 64 * kb, n0 = 32 * nb;
#pragma unroll 8
    for (int i = 0; i < 32; ++i) { const int kk = 2 * i + (lane >> 5); scr[kk * 33 + (lane & 31)] = W[(size_t)(k0 + kk) * N + n0 + (lane & 31)]; }
    asm volatile("s_waitcnt lgkmcnt(0)" ::: "memory");
    const int c = lane & 7;
#pragma unroll
    for (int j = 0; j < 4; ++j) { const int n = (lane >> 3) + 8 * j; const LAS float* sp = scr + (8 * c) * 33 + n;
        const float cm = __uint_as_float(cmax[n0 + n]); const float inv = cm > 0.f ? 127.f / cm : 0.f;
        u32 b[8];
#pragma unroll
        for (int e = 0; e < 8; ++e) b[e] = (u32)((int)rintf(sp[e * 33] * inv)) & 0xffu;
        u32x2 o; o.x = b[0] | (b[1] << 8) | (b[2] << 16) | (b[3] << 24); o.y = b[4] | (b[5] << 8) | (b[6] << 16) | (b[7] << 24);
        *(u32x2*)(WT + (size_t)(n0 + n) * K + k0 + 8 * c) = o; }
    asm volatile("s_waitcnt lgkmcnt(0)" ::: "memory");
}
__device__ __forceinline__ void ph_transpose_weights_i8(const Params& p, unsigned char* smem) {
    const int lane = TID() & 63, wave = TID() >> 6;
    LAS float* scr = (LAS float*)((LAS unsigned char*)smem + 32768 + wave * 12288);
    const int gw = blockIdx.x * 8 + wave, NGW = gridDim.x * 8;
    const unsigned* CM = (const unsigned*)(p.ws + OFF_CTL + OFF_CMAX); float* WSC = (float*)(p.ws + OFF_WSC);
    for (int i = blockIdx.x * NTHR + TID(); i < 7424 + 4608; i += gridDim.x * NTHR) WSC[i] = __uint_as_float(CM[i]) * (1.f / 127.f);
    constexpr int I_AB = 32 * (7232 / 32), I_CD = 32 * (4608 / 32);
    for (int it = gw; it < I_AB + I_CD; it += NGW) {
        if (it < I_AB) p0_transpose_item_i8(p.ab_w_in, 2048, 7232, p.ws + OFF_WT_AB, CM, scr, it, lane);
        else p0_transpose_item_i8(p.cd_w_in, 2048, 4608, p.ws + OFF_WT_CD, CM + 7424, scr, it - I_AB, lane);
    }
}
__device__ __forceinline__ void ph_transpose_weights(const Params& p, unsigned char* smem) {
    const int lane = TID() & 63, wave = TID() >> 6;
    LAS float* scr = (LAS float*)((LAS unsigned char*)smem + 32768 + wave * 12288);
    const int gw = blockIdx.x * 8 + wave, NGW = gridDim.x * 8;
    constexpr int I_SQ = 32 * 64;
    constexpr int NITEMS = 4 * I_SQ;
    for (int it = gw; it < NITEMS; it += NGW) {
        int r = it;
        if (r < I_SQ) { p0_transpose_item(p.ab_w_out, 2048, 2048, (bf16_t*)(p.ws + OFF_WT_ABOUT), scr, r, lane); continue; } r -= I_SQ;
        if (r < I_SQ) { p0_transpose_item(p.cd_w_out, 2048, 2048, (bf16_t*)(p.ws + OFF_WT_CDOUT), scr, r, lane); continue; } r -= I_SQ;
        if (r < I_SQ) { p0_transpose_item(p.peer_w_q, 2048, 2048, (bf16_t*)(p.ws + OFF_WT_PQ0), scr, r, lane); continue; } r -= I_SQ;
        p0_transpose_item(p.peer_w_q + (size_t)2048 * 2048, 2048, 2048, (bf16_t*)(p.ws + OFF_WT_PQ1), scr, r, lane);
    }
}

__device__ __forceinline__ void ph_mod(const Params& p, unsigned char* smem) {
    float* sc = (float*)smem;
    f32x4* red = (f32x4*)(smem + 16384);
    for (int i = TID(); i < 2048; i += NTHR) { sc[i] = siluf(p.c[i]); sc[2048 + i] = siluf(p.c_ctx[i]); }
    __syncthreads();
    float* modv = (float*)(p.ws + OFF_MODV);
    const int lane = TID() & 63, wave = TID() >> 6, cl = lane & 31, kp = lane >> 5;
    constexpr int C4 = 3072;
    for (int u = blockIdx.x; u < 2 * 96; u += gridDim.x) {
        const int l = u / 96, c4 = (u % 96) * 32 + cl;
        const f32x4* W = (const f32x4*)(p.mod_w + (size_t)l * 2048 * 12288) + c4;
        f32x4 a0 = {0.f, 0.f, 0.f, 0.f}, a1 = {0.f, 0.f, 0.f, 0.f};
        const int k0 = wave * 256 + kp;
#pragma unroll 8
        for (int k = k0; k < k0 + 256; k += 2) { const f32x4 w = W[(size_t)k * C4]; a0 += w * sc[k]; a1 += w * sc[2048 + k]; }
#pragma unroll
        for (int e = 0; e < 4; ++e) { a0[e] += __shfl_xor(a0[e], 32); a1[e] += __shfl_xor(a1[e], 32); }
        if (kp == 0) { red[wave * 32 + cl] = a0; red[256 + wave * 32 + cl] = a1; }
        __syncthreads();
        if (wave < 2 && kp == 0) {
            f32x4 sm = *((const f32x4*)(p.mod_b + (size_t)l * 12288) + c4);
#pragma unroll
            for (int w = 0; w < 8; ++w) sm += red[wave * 256 + w * 32 + cl];
            *(f32x4*)(modv + (size_t)(l * 2 + wave) * 12288 + c4 * 4) = sm;
        }
        __syncthreads();
    }
}

__device__ __forceinline__ void conv_table_rows(const Params& p, int row_lo, int row_hi);
__device__ __forceinline__ void ph_conv_tables(const Params& p) {
    const int lane = TID() & 63, wave = TID() >> 6;
    {   bf16_t* KEYSB = (bf16_t*)(p.ws + OFF_KEYSB);
        for (int i = blockIdx.x * NTHR + TID(); i < 2 * 8 * 2 * 128 * 128 / 4; i += gridDim.x * NTHR) { const f32x4 v = ((const f32x4*)p.peer_sub_keys)[i]; u32x2 o; o.x = pk2(v.x, v.y); o.y = pk2(v.z, v.w); ((u32x2*)KEYSB)[i] = o; } }
    conv_table_rows(p, 0, 2 * 16384);
}
__device__ __forceinline__ void conv_table_rows(const Params& p, int row_lo, int row_hi) {
    const int lane = TID() & 63, wave = TID() >> 6;
    for (int row = row_lo + blockIdx.x * 8 + wave; row < row_hi; row += gridDim.x * 8) {
        const int t = row >> 14, e = row & 16383; const int l = t >> 1;
        const f32x4* src = (const f32x4*)(((t & 1) ? p.peer_v : p.peer_u) + ((size_t)l * 16384 + e) * 2048);
        f32x4 v[8]; float am = 0.f;
#pragma unroll
        for (int j = 0; j < 8; ++j) { v[j] = src[lane + 64 * j]; am = fmaxf(am, fmaxf(fmaxf(fabsf(v[j].x), fabsf(v[j].y)), fmaxf(fabsf(v[j].z), fabsf(v[j].w)))); }
        am = fmaxf(am, 1e-30f);
        const float sc = bf2f((bf16_t)f2bf(am * (1.f / 7.f))); const float inv = frcp(sc);
        u32 w[4];
#pragma unroll
        for (int d = 0; d < 4; ++d) { const f32x4 a = v[2 * d], b = v[2 * d + 1];
            const int q0 = min(max((int)rintf(a.x * inv), -7), 7) + 8, q1 = min(max((int)rintf(a.y * inv), -7), 7) + 8, q2 = min(max((int)rintf(a.z * inv), -7), 7) + 8, q3 = min(max((int)rintf(a.w * inv), -7), 7) + 8;
            const int q4 = min(max((int)rintf(b.x * inv), -7), 7) + 8, q5 = min(max((int)rintf(b.y * inv), -7), 7) + 8, q6 = min(max((int)rintf(b.z * inv), -7), 7) + 8, q7 = min(max((int)rintf(b.w * inv), -7), 7) + 8;
            w[d] = (u32)q0 | ((u32)q1 << 4) | ((u32)q2 << 8) | ((u32)q3 << 12) | ((u32)q4 << 16) | ((u32)q5 << 20) | ((u32)q6 << 24) | ((u32)q7 << 28); }
        unsigned char* tb = p.ws + (t == 0 ? OFF_TU0 : t == 1 ? OFF_TV0 : t == 2 ? OFF_TU1 : OFF_TV1);
        *(u32x4*)(tb + (size_t)e * 1024 + lane * 16) = (u32x4){w[0], w[1], w[2], w[3]};
        ((bf16_t*)(tb + 32 * MiB))[(size_t)e * 64 + lane] = (bf16_t)f2bf(sc);
    }
}

__device__ __forceinline__ void ph_norm(const Params& p, int l, int a, const float* lat_src, const float* ctx_src, int nrows, bool write_q = false, const bf16_t* Y = nullptr, float* dst_lat = nullptr, float* dst_ctx = nullptr, bool write_i8 = false) {
    const int lane = TID() & 63, wave = TID() >> 6;
    const int gw = blockIdx.x * 8 + wave, NGW = gridDim.x * 8;
    const f32x4* g4 = (const f32x4*)(p.norm_g + (size_t)(l * 2 + a) * 2048);
    const float* modv = (const float*)(p.ws + OFF_MODV);
    bf16_t* H = (bf16_t*)(p.ws + OFF_H);
    for (int m = gw; m < nrows; m += NGW) {
        const bool isc = m >= NL;
        const f32x4* src = (const f32x4*)(isc ? ctx_src + (size_t)(m - NL) * DM : lat_src + (size_t)m * DM);
        const float* mv = modv + (size_t)(l * 2 + (isc ? 1 : 0)) * 12288 + (a ? 3 : 0) * 2048;
        const f32x4* sh4 = (const f32x4*)mv; const f32x4* sc4 = (const f32x4*)(mv + 2048);
        f32x4 v[8]; float ss = 0.f;
        if (Y) {
            const f32x4* gt4 = (const f32x4*)(modv + (size_t)(l * 2 + (isc ? 1 : 0)) * 12288 + 2 * 2048);
            const u32x2* y2 = (const u32x2*)(Y + (size_t)m * DM);
            f32x4* dst = (f32x4*)(isc ? dst_ctx + (size_t)(m - NL) * DM : dst_lat + (size_t)m * DM);
#pragma unroll
            for (int j = 0; j < 8; ++j) { const int i4 = lane + 64 * j; const u32x2 yy = y2[i4]; const f32x4 yf = {bfl(yy.x), bfh(yy.x), bfl(yy.y), bfh(yy.y)};
                v[j] = src[i4] + gt4[i4] * yf; dst[i4] = v[j]; ss += v[j].x * v[j].x + v[j].y * v[j].y + v[j].z * v[j].z + v[j].w * v[j].w; }
        } else {
#pragma unroll
            for (int j = 0; j < 8; ++j) { v[j] = src[lane + 64 * j]; ss += v[j].x * v[j].x + v[j].y * v[j].y + v[j].z * v[j].z + v[j].w * v[j].w; }
        }
        ss = wave_sum(ss);
        const float r = rsqrtf(ss * (1.f / 2048.f) + 1e-6f);
        u32x2* o = (u32x2*)(H + (size_t)m * DM);
        float am = 0.f;
#pragma unroll
        for (int j = 0; j < 8; ++j) {
            const int i4 = lane + 64 * j; const f32x4 gg = g4[i4], sh = sh4[i4], sc = sc4[i4];
            const f32x4 y = v[j] * r * gg * (sc + 1.f) + sh; v[j] = y;
            am = fmaxf(am, fmaxf(fmaxf(fabsf(y.x), fabsf(y.y)), fmaxf(fabsf(y.z), fabsf(y.w))));
            u32x2 w; w.x = pk2(y.x, y.y); w.y = pk2(y.z, y.w); o[i4] = w;
        }
        if (write_i8) {
            const float am8 = fmaxf(wave_max(am), 1e-30f); const float inv8 = 127.f / am8;
            u32* o8 = (u32*)(p.ws + OFF_H8 + (size_t)m * DM);
#pragma unroll
            for (int j = 0; j < 8; ++j) o8[lane + 64 * j] = ((u32)((int)rintf(v[j].x * inv8)) & 0xffu) | (((u32)((int)rintf(v[j].y * inv8)) & 0xffu) << 8) | (((u32)((int)rintf(v[j].z * inv8)) & 0xffu) << 16) | (((u32)((int)rintf(v[j].w * inv8)) & 0xffu) << 24);
            if (lane == 0) ((float*)(p.ws + OFF_HS8))[m] = am8 * (1.f / 127.f);
        }
        if (write_q) {
            am = fmaxf(wave_max(am), 1e-30f); const float inv = 127.f / am;
            u32* oq = (u32*)(p.ws + OFF_HQ + (size_t)m * DM);
#pragma unroll
            for (int j = 0; j < 8; ++j) oq[lane * 8 + j] = ((u32)((int)rintf(v[j].x * inv)) & 0xffu) | (((u32)((int)rintf(v[j].y * inv)) & 0xffu) << 8) | (((u32)((int)rintf(v[j].z * inv)) & 0xffu) << 16) | (((u32)((int)rintf(v[j].w * inv)) & 0xffu) << 24);
            if (lane == 0) ((float*)(p.ws + OFF_HQS))[m] = am * (1.f / 127.f);
        }
    }
}

struct EpiStoreBf16 {
    bf16_t* O; int ld;
    __device__ __forceinline__ void operator()(int m, int n, f32x4 v) const { u32x2 w; w.x = pk2(v.x, v.y); w.y = pk2(v.z, v.w); *(u32x2*)(O + (size_t)m * ld + n) = w; }
};
struct EpiResidual {
    const float* xin_lat; const float* xin_ctx; float* xout_lat; float* xout_ctx; const float* gate_lat; const float* gate_ctx;
    __device__ __forceinline__ void operator()(int m, int n, f32x4 v) const {
        if (m < NL) { const f32x4 b = *(const f32x4*)(xin_lat + (size_t)m * DM + n), g = *(const f32x4*)(gate_lat + n); *(f32x4*)(xout_lat + (size_t)m * DM + n) = b + g * v; }
        else { const int mc = m - NL; const f32x4 b = *(const f32x4*)(xin_ctx + (size_t)mc * DM + n), g = *(const f32x4*)(gate_ctx + n); *(f32x4*)(xout_ctx + (size_t)mc * DM + n) = b + g * v; }
    }
};
template <class Epi>
__device__ __forceinline__ void ph_gemm_naive(const bf16_t* A, const float* W, int M, int N, const Epi& E, unsigned char* smem) {
    float* As = (float*)smem;
    float* Ws = As + 16 * 132;
    const int tid = TID(), ty = tid >> 4, tx = tid & 15;
    const int nTm = M / 128, nTn = N / 64, ntile = nTm * nTn;
    for (int t = blockIdx.x; t < ntile; t += gridDim.x) {
        const int tm = t % nTm, tn = t / nTm; const int m0 = tm * 128, n0 = tn * 64;
        f32x4 acc[4];
#pragma unroll
        for (int i = 0; i < 4; ++i) acc[i] = (f32x4){0.f, 0.f, 0.f, 0.f};
        for (int k0 = 0; k0 < 2048; k0 += 16) {
            { const int r = tid >> 2, kq = (tid & 3) * 4; const u32x2 a = *(const u32x2*)(A + (size_t)(m0 + r) * 2048 + k0 + kq);
              As[(kq + 0) * 132 + r] = __uint_as_float(a.x << 16); As[(kq + 1) * 132 + r] = __uint_as_float(a.x & 0xffff0000u);
              As[(kq + 2) * 132 + r] = __uint_as_float(a.y << 16); As[(kq + 3) * 132 + r] = __uint_as_float(a.y & 0xffff0000u); }
            { const int kk = tid >> 5, nn = (tid & 31) * 2; const float2 w = *(const float2*)(W + (size_t)(k0 + kk) * N + n0 + nn); Ws[kk * 64 + nn] = w.x; Ws[kk * 64 + nn + 1] = w.y; }
            __syncthreads();
#pragma unroll
            for (int k = 0; k < 16; ++k) {
                const f32x4 a = *(const f32x4*)(As + k * 132 + ty * 4); const f32x4 b = *(const f32x4*)(Ws + k * 64 + tx * 4);
                acc[0] += b * a.x; acc[1] += b * a.y; acc[2] += b * a.z; acc[3] += b * a.w;
            }
            __syncthreads();
        }
#pragma unroll
        for (int i = 0; i < 4; ++i) E(m0 + ty * 4 + i, n0 + tx * 4, acc[i]);
    }
}

__device__ __forceinline__ int tile_pos(int z, int tt);
__device__ __forceinline__ float wave_incl_scan(float v, int lane, float& total);
__device__ __forceinline__ void ph_prep_ab(const Params& p, unsigned char* smem) {
    const bf16_t* PAB = (const bf16_t*)(p.ws + OFF_PAB);
    bf16_t* AQ = (bf16_t*)(p.ws + OFF_AQ); bf16_t* AK = (bf16_t*)(p.ws + OFF_AK); bf16_t* AKT = (bf16_t*)(p.ws + OFF_AKT);
    bf16_t* AVT = (bf16_t*)(p.ws + OFF_AVT); bf16_t* BVT = (bf16_t*)(p.ws + OFF_BVT);
    const int tid = TID();
    {
        bf16_t* tK = (bf16_t*)smem; bf16_t* tV = tK + 64 * 128; bf16_t* tB = tV + 64 * 128;
        const int c16 = tid & 15, qk = (tid >> 4) & 1, tg = tid >> 5;
        for (int u = blockIdx.x; u < 132 * 8; u += gridDim.x) {
            const int tt = u >> 3, h = u & 7; const int m0 = tt * 64; const int lo = m0 < NL ? 0 : NL, hi = m0 < NL ? NL : NT;
            {
                const int ch0 = qk * 1024 + h * 128 + c16 * 8;
                float w0[8], w1[8], w2[8], bs[8];
#pragma unroll
                for (int q = 0; q < 2; ++q) { const f32x4 a0 = *(const f32x4*)(p.ab_conv_w + ch0 + q * 4), a1 = *(const f32x4*)(p.ab_conv_w + 2048 + ch0 + q * 4), a2 = *(const f32x4*)(p.ab_conv_w + 4096 + ch0 + q * 4), bb = *(const f32x4*)(p.ab_conv_b + ch0 + q * 4);
#pragma unroll
                    for (int e = 0; e < 4; ++e) { w0[q * 4 + e] = a0[e]; w1[q * 4 + e] = a1[e]; w2[q * 4 + e] = a2[e]; bs[q * 4 + e] = bb[e]; } }
                u32x4 rw[6];
#pragma unroll
                for (int i = 0; i < 6; ++i) { const int m = m0 + tg * 4 + i - 1; rw[i] = (m >= lo && m < hi) ? *(const u32x4*)(PAB + (size_t)m * PAB_LD + ch0) : (u32x4){0u, 0u, 0u, 0u}; }
                const float sc = qk ? 0.08838834764831845f : 1.f;
                bf16_t* dst = (qk ? AK : AQ) + ((size_t)h * NT + m0 + tg * 4) * 128 + c16 * 8;
#pragma unroll
                for (int i = 0; i < 4; ++i) {
                    float o[8];
#pragma unroll
                    for (int e2 = 0; e2 < 4; ++e2) {
                        const u32 xm = rw[i][e2], x0 = rw[i + 1][e2], xp = rw[i + 2][e2];
                        o[2 * e2] = siluf(w0[2 * e2] * bfl(xm) + w1[2 * e2] * bfl(x0) + w2[2 * e2] * bfl(xp) + bs[2 * e2]) * sc;
                        o[2 * e2 + 1] = siluf(w0[2 * e2 + 1] * bfh(xm) + w1[2 * e2 + 1] * bfh(x0) + w2[2 * e2 + 1] * bfh(xp) + bs[2 * e2 + 1]) * sc; }
                    u32x4 ov; ov.x = pk2(o[0], o[1]); ov.y = pk2(o[2], o[3]); ov.z = pk2(o[4], o[5]); ov.w = pk2(o[6], o[7]);
                    *(u32x4*)(dst + (size_t)i * 128) = ov;
                    if (qk) *(u32x4*)(tK + (tg * 4 + i) * 128 + c16 * 8) = ov;
                }
            }
#pragma unroll
            for (int i = 0; i < 2; ++i) { const int e = tid + NTHR * i; const int tau = e >> 4, c = e & 15;
                *(u32x4*)(tV + tau * 128 + c * 8) = *(const u32x4*)(PAB + (size_t)(m0 + tau) * PAB_LD + CA_V + h * 128 + c * 8);
                *(u32x4*)(tB + tau * 128 + c * 8) = *(const u32x4*)(PAB + (size_t)(m0 + tau) * PAB_LD + CB_V + h * 128 + c * 8); }
            __syncthreads();
            for (int e = tid; e < 128 * 8; e += NTHR) {
                const int d = e >> 3, c8 = e & 7;
                u32x4 ok, ov, ob; u32 tk[8], tv[8], tb[8];
#pragma unroll
                for (int j = 0; j < 8; ++j) { tk[j] = tK[(c8 * 8 + j) * 128 + d]; tv[j] = tV[(c8 * 8 + j) * 128 + d]; tb[j] = tB[(c8 * 8 + j) * 128 + d]; }
                ok.x = tk[0] | (tk[1] << 16); ok.y = tk[2] | (tk[3] << 16); ok.z = tk[4] | (tk[5] << 16); ok.w = tk[6] | (tk[7] << 16);
                ov.x = tv[0] | (tv[1] << 16); ov.y = tv[2] | (tv[3] << 16); ov.z = tv[4] | (tv[5] << 16); ov.w = tv[6] | (tv[7] << 16);
                ob.x = tb[0] | (tb[1] << 16); ob.y = tb[2] | (tb[3] << 16); ob.z = tb[4] | (tb[5] << 16); ob.w = tb[6] | (tb[7] << 16);
                *(u32x4*)(AKT + ((size_t)h * 128 + d) * NT + m0 + c8 * 8) = ok;
                *(u32x4*)(AVT + ((size_t)h * 144 + d) * NT + m0 + c8 * 8) = ov;
                *(u32x4*)(BVT + ((size_t)h * 128 + d) * NT + m0 + c8 * 8) = ob;
            }
            if (tid < 128) { const int rr = 128 + (tid >> 3), c8 = tid & 7; const u32 val = rr == 128 ? 0x3f803f80u : 0u;
                *(u32x4*)(AVT + ((size_t)h * 144 + rr) * NT + m0 + c8 * 8) = (u32x4){val, val, val, val}; }
            __syncthreads();
        }
    }
    {
        float* IG = (float*)(p.ws + OFF_IG); float* LF = (float*)(p.ws + OFF_LF);
        for (int i = blockIdx.x * NTHR + tid; i < NT * 32; i += gridDim.x * NTHR) {
            const int m = i >> 5, r = i & 31; const int z = r >> 4, g = (r >> 3) & 1, h = r & 7;
            const float val = bf2f(PAB[(size_t)m * PAB_LD + CA_G + r]) + p.ab_gate_b[r];
            if (g == 0) IG[(size_t)(z * 8 + h) * NT + m] = val; else LF[(size_t)(z * 8 + h) * NT + m] = logsigf(val);
        }
    }
    {
        bf16_t* BQS = (bf16_t*)(p.ws + OFF_BQS); bf16_t* BKS = (bf16_t*)(p.ws + OFF_BKS); bf16_t* BKST = (bf16_t*)(p.ws + OFF_BKENDT);
        float* GDEC = (float*)(p.ws + OFF_GDEC);
        const int lane = tid & 63, wv = __builtin_amdgcn_readfirstlane(tid >> 6);
        float awr[16][8], abr[8]; int zcur = -1, c0cur = -1;
        for (int job = ((int)gridDim.x - 1 - (int)blockIdx.x) * 8 + wv; job < 2 * 132 * 64; job += gridDim.x * 8) {
            const int z = job / (132 * 64), r = job % (132 * 64), tt = r >> 6, c0 = (r & 63) * 8, h = c0 >> 6; const int m = tt * 64 + lane;
            const bf16_t* row = PAB + (size_t)m * PAB_LD;
            const u32x4 lr0 = *(const u32x4*)(row + CB_LR + z * 16), lr1 = *(const u32x4*)(row + CB_LR + z * 16 + 8);
            const u32x4 qv = *(const u32x4*)(row + CB_Q + c0), kv = *(const u32x4*)(row + CB_K + c0);
            const float x[16] = {bfl(lr0.x), bfh(lr0.x), bfl(lr0.y), bfh(lr0.y), bfl(lr0.z), bfh(lr0.z), bfl(lr0.w), bfh(lr0.w), bfl(lr1.x), bfh(lr1.x), bfl(lr1.y), bfh(lr1.y), bfl(lr1.z), bfh(lr1.z), bfl(lr1.w), bfh(lr1.w)};
            if (z != zcur || c0 != c0cur) {
#pragma unroll
                for (int rr = 0; rr < 16; ++rr) { const f32x4 a0 = *(const f32x4*)(p.ab_alpha_w2 + (size_t)(z * 16 + rr) * 512 + c0), a1 = *(const f32x4*)(p.ab_alpha_w2 + (size_t)(z * 16 + rr) * 512 + c0 + 4);
                    awr[rr][0] = a0.x; awr[rr][1] = a0.y; awr[rr][2] = a0.z; awr[rr][3] = a0.w; awr[rr][4] = a1.x; awr[rr][5] = a1.y; awr[rr][6] = a1.z; awr[rr][7] = a1.w; }
                { const f32x4 b0 = *(const f32x4*)(p.ab_alpha_b + z * 512 + c0), b1 = *(const f32x4*)(p.ab_alpha_b + z * 512 + c0 + 4);
                  abr[0] = b0.x; abr[1] = b0.y; abr[2] = b0.z; abr[3] = b0.w; abr[4] = b1.x; abr[5] = b1.y; abr[6] = b1.z; abr[7] = b1.w; }
                zcur = z; c0cur = c0;
            }
            float za[8];
#pragma unroll
            for (int j = 0; j < 8; ++j) za[j] = abr[j];
#pragma unroll
            for (int rr = 0; rr < 16; ++rr)
#pragma unroll
                for (int j = 0; j < 8; ++j) za[j] += x[rr] * awr[rr][j];
            const float qf[8] = {bfl(qv.x), bfh(qv.x), bfl(qv.y), bfh(qv.y), bfl(qv.z), bfh(qv.z), bfl(qv.w), bfh(qv.w)};
            const float kf[8] = {bfl(kv.x), bfh(kv.x), bfl(kv.y), bfh(kv.y), bfl(kv.z), bfh(kv.z), bfl(kv.w), bfh(kv.w)};
            float qo[8], ko[8], tots[8];
#pragma unroll
            for (int j = 0; j < 8; ++j) {
                const float lg = -__logf(1.f + __expf(-za[j])) * (1.f / 16.f);
                float tot; const float pre = wave_incl_scan(lg, lane, tot); const float run = z ? tot - pre + lg : pre;
                qo[j] = qf[j] * 0.125f * __expf(run); ko[j] = kf[j] * __expf(-run); tots[j] = tot;
            }
            u32x4 oq, ok; oq.x = pk2(qo[0], qo[1]); oq.y = pk2(qo[2], qo[3]); oq.z = pk2(qo[4], qo[5]); oq.w = pk2(qo[6], qo[7]);
            ok.x = pk2(ko[0], ko[1]); ok.y = pk2(ko[2], ko[3]); ok.z = pk2(ko[4], ko[5]); ok.w = pk2(ko[6], ko[7]);
            *(u32x4*)(BQS + ((size_t)(z * 8 + h) * NT + m) * 64 + (c0 & 63)) = oq;
            *(u32x4*)(BKS + ((size_t)(z * 8 + h) * NT + m) * 64 + (c0 & 63)) = ok;
#pragma unroll
            for (int j = 0; j < 8; ++j) BKST[((size_t)(z * 8 + h) * 64 + (c0 & 63) + j) * NT + m] = (bf16_t)(j & 1 ? (((j >> 1) == 0 ? ok.x : (j >> 1) == 1 ? ok.y : (j >> 1) == 2 ? ok.z : ok.w) >> 16) : (((j >> 1) == 0 ? ok.x : (j >> 1) == 1 ? ok.y : (j >> 1) == 2 ? ok.z : ok.w) & 0xffffu));
            if (lane < 8) { float tv = tots[0];
#pragma unroll
                for (int j = 1; j < 8; ++j) tv = lane == j ? tots[j] : tv;
                GDEC[((size_t)(z * 8 + h) * 132 + tile_pos(z, tt)) * 64 + (c0 & 63) + lane] = __expf(tv); }
        }
    }
}

__device__ __forceinline__ int unit_kind(int u) { return (u + (u >> 8)) & 1; }
__device__ __forceinline__ int tile_pos(int z, int tt) { if (tt < 128) return z == 0 ? 4 + tt : 4 + (127 - tt); const int c = tt - 128; return z == 0 ? c : 3 - c; }
typedef short bf16x8_t __attribute__((ext_vector_type(8)));
#define MFMA16(a, b, c) __builtin_amdgcn_mfma_f32_16x16x32_bf16(a, b, c, 0, 0, 0)
__device__ __forceinline__ bf16x8_t ld8(const bf16_t* q) { return *(const bf16x8_t*)q; }
template <int N> __device__ __forceinline__ float row_shr_z(float v) { return __int_as_float(__builtin_amdgcn_update_dpp(0, __float_as_int(v), 0x110 | N, 0xF, 0xF, true)); }
__device__ __forceinline__ float wave_incl_scan(float v, int lane, float& total) {
    v += row_shr_z<1>(v); v += row_shr_z<2>(v); v += row_shr_z<4>(v); v += row_shr_z<8>(v);
    const float t0 = __int_as_float(__builtin_amdgcn_readlane(__float_as_int(v), 15)), t1 = __int_as_float(__builtin_amdgcn_readlane(__float_as_int(v), 31));
    const float t2 = __int_as_float(__builtin_amdgcn_readlane(__float_as_int(v), 47)), t3 = __int_as_float(__builtin_amdgcn_readlane(__float_as_int(v), 63));
    const int q = lane >> 4;
    v += (q >= 1 ? t0 : 0.f) + (q >= 2 ? t1 : 0.f) + (q >= 3 ? t2 : 0.f);
    total = ((t0 + t1) + t2) + t3;
    return v;
}

__device__ __forceinline__ void ph_sa(const Params& p, unsigned char* smem, int abl = 0) {
    const bf16_t* AKT = (const bf16_t*)(p.ws + OFF_AKT); const bf16_t* AVT = (const bf16_t*)(p.ws + OFF_AVT);
    const bf16_t* BVT = (const bf16_t*)(p.ws + OFF_BVT); const bf16_t* BKST = (const bf16_t*)(p.ws + OFF_BKENDT);
    const float* IG = (const float*)(p.ws + OFF_IG); const float* LF = (const float*)(p.ws + OFF_LF);
    bf16_t* DCT = (bf16_t*)(p.ws + OFF_DCT); bf16_t* DST = (bf16_t*)(p.ws + OFF_DST); float* DEC = (float*)(p.ws + OFF_DEC); const float* GDEC = (const float*)(p.ws + OFF_GDEC);
    const int tid = TID(), lane = tid & 63, wave = tid >> 6, lr = lane & 15, lq = lane >> 4;
    constexpr int T_V = 0, T_K = 144 * 144, BUF = 144 * 144 + 64 * 144;
    float* wl = (float*)(smem + 2 * BUF) + wave * 64;
    bf16x8_t kr[2], gv[2]; float lf = 0.f, ig = 0.f; f32x4 gd[4]; u32x4 st[4];
#define SA_DEC(u_) const int z_ = (u_) / 1056, r2_ = (u_) % 1056, h_ = r2_ / 132, tt_ = r2_ % 132; const int m0_ = tt_ * 64, zh_ = z_ * 8 + h_, pos_ = tile_pos(z_, tt_)
#define SA_LOADW(u_) do { SA_DEC(u_); lf = LF[(size_t)zh_ * NT + m0_ + lane]; ig = IG[(size_t)zh_ * NT + m0_ + lane]; \
        _Pragma("unroll") for (int ks = 0; ks < 2; ++ks) { kr[ks] = ld8(AKT + ((size_t)h_ * 128 + wave * 16 + lr) * NT + m0_ + ks * 32 + 8 * lq); gv[ks] = ld8(BVT + ((size_t)h_ * 128 + wave * 16 + lr) * NT + m0_ + ks * 32 + 8 * lq); } \
        _Pragma("unroll") for (int nt = 0; nt < 4; ++nt) gd[nt] = *(const f32x4*)(GDEC + (size_t)(zh_ * 132 + pos_) * 64 + nt * 16 + lq * 4); } while (0)
#define SA_LOADT(u_) do { SA_DEC(u_); (void)pos_; _Pragma("unroll") for (int i = 0; i < 3; ++i) { const int pc = min(tid + NTHR * i, 1151); st[i] = *(const u32x4*)(AVT + ((size_t)h_ * 144 + (pc >> 3)) * NT + m0_ + (pc & 7) * 8); } \
        st[3] = *(const u32x4*)(BKST + ((size_t)zh_ * 64 + (tid >> 3)) * NT + m0_ + (tid & 7) * 8); } while (0)
#define SA_STORET(bo) do { _Pragma("unroll") for (int i = 0; i < 3; ++i) { const int pc = tid + NTHR * i; if (pc < 1152) *(u32x4*)(smem + (bo) + T_V + (pc >> 3) * 144 + (pc & 7) * 16) = st[i]; } \
        *(u32x4*)(smem + (bo) + T_K + (tid >> 3) * 144 + (tid & 7) * 16) = st[3]; } while (0)
    const int u0 = min((int)blockIdx.x, 2111);
    SA_LOADT(u0); SA_LOADW(u0);
    __syncthreads();
    SA_STORET(0);
    __syncthreads();
    { const int u1 = min(u0 + (int)gridDim.x, 2111); SA_LOADT(u1); }
    int cnt = 0;
    for (int u = blockIdx.x; u < 2112; u += gridDim.x, ++cnt) {
        const int z = u / 1056, r2 = u % 1056, h = r2 / 132, tt = r2 % 132; const int pos = tile_pos(z, tt), zh = z * 8 + h;
        const unsigned char* Vl = smem + (cnt & 1) * BUF + T_V; const unsigned char* Kl = smem + (cnt & 1) * BUF + T_K;
        const float lf_ = lf, ig_ = ig; const bf16x8_t kr0 = kr[0], kr1 = kr[1], gv0 = gv[0], gv1 = gv[1]; const f32x4 gd0 = gd[0], gd1 = gd[1], gd2 = gd[2], gd3 = gd[3];
        { const int un = min(u + (int)gridDim.x, 2111); SA_LOADW(un); }
        float tot; const float pre = wave_incl_scan(lf_, lane, tot); const float b = z ? tot - pre + lf_ : pre;
        wl[lane] = __expf(tot - b + ig_);
        if (wave == 0 && lane == 0) DEC[zh * 132 + pos] = __expf(tot);
        bf16x8_t ka[2];
#pragma unroll
        for (int ks = 0; ks < 2; ++ks) {
            const bf16x8_t krr = ks ? kr1 : kr0;
            const f32x4 w0 = *(const f32x4*)(wl + ks * 32 + 8 * lq), w1 = *(const f32x4*)(wl + ks * 32 + 8 * lq + 4);
            const float wv[8] = {w0.x, w0.y, w0.z, w0.w, w1.x, w1.y, w1.z, w1.w};
            u32 pk[4];
#pragma unroll
            for (int j = 0; j < 4; ++j) pk[j] = pk2(bf2f((bf16_t)krr[2 * j]) * wv[2 * j], bf2f((bf16_t)krr[2 * j + 1]) * wv[2 * j + 1]);
            ka[ks] = __builtin_bit_cast(bf16x8_t, (u32x4){pk[0], pk[1], pk[2], pk[3]});
        }
        bf16_t* o = DCT + (size_t)(zh * 132 + pos) * (144 * 128) + (size_t)wave * (144 * 16) + lq * 4;
#pragma unroll
        for (int t9 = 0; t9 < 9; ++t9) { f32x4 acc = {0.f, 0.f, 0.f, 0.f};
#pragma unroll
            for (int ks = 0; ks < 2; ++ks) { const bf16x8_t vb = *(const bf16x8_t*)(Vl + (t9 * 16 + lr) * 144 + (ks * 32 + 8 * lq) * 2); acc = MFMA16(ka[ks], vb, acc); }
            u32x2 w; w.x = pk2(acc[0], acc[1]); w.y = pk2(acc[2], acc[3]); *(u32x2*)(o + (size_t)(t9 * 16 + lr) * 16) = w; }
        bf16_t* o2 = DST + (size_t)(zh * 132 + pos) * (128 * 64) + (size_t)(wave * 16 + lr) * 64 + lq * 4;
#pragma unroll
        for (int nt = 0; nt < 4; ++nt) { f32x4 acc = {0.f, 0.f, 0.f, 0.f};
#pragma unroll
            for (int ks = 0; ks < 2; ++ks) { const bf16x8_t kb = *(const bf16x8_t*)(Kl + (nt * 16 + lr) * 144 + (ks * 32 + 8 * lq) * 2); acc = MFMA16(kb, ks ? gv1 : gv0, acc); }
            acc *= (nt == 0 ? gd0 : nt == 1 ? gd1 : nt == 2 ? gd2 : gd3);
            u32x2 w; w.x = pk2(acc[0], acc[1]); w.y = pk2(acc[2], acc[3]); *(u32x2*)(o2 + nt * 16) = w; }
        SA_STORET(((cnt + 1) & 1) * BUF);
        __syncthreads();
        { const int u2 = min(u + 2 * (int)gridDim.x, 2111); SA_LOADT(u2); }
    }
#undef SA_DEC
#undef SA_LOADW
#undef SA_LOADT
#undef SA_STORET
}

__device__ __forceinline__ void ph_sb(const Params& p) {
    bf16_t* DCT = (bf16_t*)(p.ws + OFF_DCT); bf16_t* DST = (bf16_t*)(p.ws + OFF_DST); const float* DEC = (const float*)(p.ws + OFF_DEC); const float* GDEC = (const float*)(p.ws + OFF_GDEC);
    constexpr int NA = 16 * 4608, NB = 16 * 2048;
    for (int gt = blockIdx.x * NTHR + TID(); gt < NA + NB; gt += gridDim.x * NTHR) {
        if (gt < NA) {
            const int zh = gt / 4608, e4 = gt % 4608; bf16_t* ptr = DCT + (size_t)zh * 132 * 18432 + e4 * 4; const float* dec = DEC + zh * 132;
            float c0 = 0.f, c1 = 0.f, c2 = 0.f, c3 = 0.f;
#pragma unroll 4
            for (int q = 0; q < 132; ++q) { const u32x2 d = *(const u32x2*)(ptr + (size_t)q * 18432); const float dc = dec[q];
                u32x2 o; o.x = pk2(c0, c1); o.y = pk2(c2, c3); *(u32x2*)(ptr + (size_t)q * 18432) = o;
                c0 = dc * c0 + __uint_as_float(d.x << 16); c1 = dc * c1 + __uint_as_float(d.x & 0xffff0000u); c2 = dc * c2 + __uint_as_float(d.y << 16); c3 = dc * c3 + __uint_as_float(d.y & 0xffff0000u); }
        } else {
            const int g = gt - NA; const int zh = g / 2048, e4 = g % 2048; const int dk0 = (e4 * 4) & 63; bf16_t* ptr = DST + (size_t)zh * 132 * 8192 + e4 * 4; const float* dec = GDEC + (size_t)zh * 132 * 64 + dk0;
            float c0 = 0.f, c1 = 0.f, c2 = 0.f, c3 = 0.f;
#pragma unroll 4
            for (int q = 0; q < 132; ++q) { const u32x2 d = *(const u32x2*)(ptr + (size_t)q * 8192); const f32x4 dc = *(const f32x4*)(dec + q * 64);
                u32x2 o; o.x = pk2(c0, c1); o.y = pk2(c2, c3); *(u32x2*)(ptr + (size_t)q * 8192) = o;
                c0 = dc.x * c0 + __uint_as_float(d.x << 16); c1 = dc.y * c1 + __uint_as_float(d.x & 0xffff0000u); c2 = dc.z * c2 + __uint_as_float(d.y << 16); c3 = dc.w * c3 + __uint_as_float(d.y & 0xffff0000u); }
        }
    }
}

struct ScTiles { static constexpr int O_Q = 0, O_K = 17408, O_V = 34816, O_C0 = 55552, O_C1 = 94720, O_P = 133888, O_BI = 150272, O_X = 55552;
                 static constexpr int G_Q0 = 0, G_Q1 = 9216, G_K0 = 18432, G_K1 = 27648, G_V = 36864, G_S0 = 55552, G_S1 = 73984; };
__device__ __forceinline__ void sc_prefetch(const Params& p, int kind, int h, int tt, int tid, u32x4 (&rg)[17]) {
    const int m0 = tt * 64;
    if (kind == 0) {
        const bf16_t* AQ = (const bf16_t*)(p.ws + OFF_AQ); const bf16_t* AK = (const bf16_t*)(p.ws + OFF_AK); const bf16_t* AVT = (const bf16_t*)(p.ws + OFF_AVT); const bf16_t* DCT = (const bf16_t*)(p.ws + OFF_DCT);
        const bf16_t* C0 = DCT + (size_t)(h * 132 + tile_pos(0, tt)) * (144 * 128); const bf16_t* C1 = DCT + (size_t)((8 + h) * 132 + tile_pos(1, tt)) * (144 * 128);
#pragma unroll
        for (int i = 0; i < 2; ++i) { const int pc = tid + NTHR * i; rg[i] = *(const u32x4*)(AQ + ((size_t)h * NT + m0 + (pc >> 4)) * 128 + (pc & 15) * 8); rg[2 + i] = *(const u32x4*)(AK + ((size_t)h * NT + m0 + (pc >> 4)) * 128 + (pc & 15) * 8); }
#pragma unroll
        for (int i = 0; i < 3; ++i) { const int pc = min(tid + NTHR * i, 1151); rg[4 + i] = *(const u32x4*)(AVT + ((size_t)h * 144 + (pc >> 3)) * NT + m0 + (pc & 7) * 8); }
#pragma unroll
        for (int i = 0; i < 5; ++i) { const int pc = min(tid + NTHR * i, 2063); const int dkt = pc / 258, rem = pc % 258; const size_t so = (size_t)(dkt * 144 + (rem >> 1)) * 16 + (rem & 1) * 8;
            rg[7 + i] = *(const u32x4*)(C0 + so); rg[12 + i] = *(const u32x4*)(C1 + so); }
    } else {
        const bf16_t* BQS = (const bf16_t*)(p.ws + OFF_BQS); const bf16_t* BKS = (const bf16_t*)(p.ws + OFF_BKS); const bf16_t* BVT = (const bf16_t*)(p.ws + OFF_BVT); const bf16_t* DST = (const bf16_t*)(p.ws + OFF_DST);
        const bf16_t* S0 = DST + (size_t)(h * 132 + tile_pos(0, tt)) * (128 * 64); const bf16_t* S1 = DST + (size_t)((8 + h) * 132 + tile_pos(1, tt)) * (128 * 64);
        { const int row = tid >> 3, c = tid & 7;
          rg[0] = *(const u32x4*)(BQS + ((size_t)h * NT + m0 + row) * 64 + c * 8); rg[1] = *(const u32x4*)(BQS + ((size_t)(8 + h) * NT + m0 + row) * 64 + c * 8);
          rg[2] = *(const u32x4*)(BKS + ((size_t)h * NT + m0 + row) * 64 + c * 8); rg[3] = *(const u32x4*)(BKS + ((size_t)(8 + h) * NT + m0 + row) * 64 + c * 8); }
#pragma unroll
        for (int i = 0; i < 2; ++i) { const int pc = tid + NTHR * i; const int row = pc >> 3, c = pc & 7;
            rg[4 + i] = *(const u32x4*)(BVT + ((size_t)h * 128 + row) * NT + m0 + c * 8); rg[6 + i] = *(const u32x4*)(S0 + (size_t)row * 64 + c * 8); rg[8 + i] = *(const u32x4*)(S1 + (size_t)row * 64 + c * 8); }
#pragma unroll
        for (int i = 10; i < 17; ++i) rg[i] = (u32x4){0u, 0u, 0u, 0u};
    }
}
__device__ __forceinline__ void sc_store(unsigned char* smem, int kind, int tid, const u32x4 (&rg)[17]) {
    if (kind == 0) {
#pragma unroll
        for (int i = 0; i < 2; ++i) { const int pc = tid + NTHR * i; *(u32x4*)(smem + ScTiles::O_Q + (pc >> 4) * 272 + (pc & 15) * 16) = rg[i]; *(u32x4*)(smem + ScTiles::O_K + (pc >> 4) * 272 + (pc & 15) * 16) = rg[2 + i]; }
#pragma unroll
        for (int i = 0; i < 3; ++i) { const int pc = tid + NTHR * i; if (pc < 1152) *(u32x4*)(smem + ScTiles::O_V + (pc >> 3) * 144 + (pc & 7) * 16) = rg[4 + i]; }
#pragma unroll
        for (int i = 0; i < 5; ++i) { const int pc = tid + NTHR * i; if (pc < 2064) { const int dkt = pc / 258, rem = pc % 258; const int lo_ = (rem >> 1) * 272 + dkt * 32 + (rem & 1) * 16;
            *(u32x4*)(smem + ScTiles::O_C0 + lo_) = rg[7 + i]; *(u32x4*)(smem + ScTiles::O_C1 + lo_) = rg[12 + i]; } }
    } else {
        { const int row = tid >> 3, c = tid & 7;
          *(u32x4*)(smem + ScTiles::G_Q0 + row * 144 + c * 16) = rg[0]; *(u32x4*)(smem + ScTiles::G_Q1 + row * 144 + c * 16) = rg[1];
          *(u32x4*)(smem + ScTiles::G_K0 + row * 144 + c * 16) = rg[2]; *(u32x4*)(smem + ScTiles::G_K1 + row * 144 + c * 16) = rg[3]; }
#pragma unroll
        for (int i = 0; i < 2; ++i) { const int pc = tid + NTHR * i; const int row = pc >> 3, c = pc & 7;
            *(u32x4*)(smem + ScTiles::G_V + row * 144 + c * 16) = rg[4 + i]; *(u32x4*)(smem + ScTiles::G_S0 + row * 144 + c * 16) = rg[6 + i]; *(u32x4*)(smem + ScTiles::G_S1 + row * 144 + c * 16) = rg[8 + i]; }
    }
}
__device__ __forceinline__ void ph_sc(const Params& p, unsigned char* smem) {
    const bf16_t* PAB = (const bf16_t*)(p.ws + OFF_PAB);
    const float* IG = (const float*)(p.ws + OFF_IG); const float* LF = (const float*)(p.ws + OFF_LF);
    bf16_t* YM = (bf16_t*)(p.ws + OFF_YM);
    const int tid = TID(), lane = tid & 63, wave = tid >> 6, lr = lane & 15, lq = lane >> 4;
    const int z = wave >> 2, mt = wave & 3, t0 = mt * 16;
    constexpr int O_Q = ScTiles::O_Q, O_K = ScTiles::O_K, O_V = ScTiles::O_V, O_C0 = ScTiles::O_C0, O_C1 = ScTiles::O_C1, O_P = ScTiles::O_P, O_BI = ScTiles::O_BI, O_X = ScTiles::O_X;
    constexpr int G_Q0 = ScTiles::G_Q0, G_Q1 = ScTiles::G_Q1, G_K0 = ScTiles::G_K0, G_K1 = ScTiles::G_K1, G_V = ScTiles::G_V, G_S0 = ScTiles::G_S0, G_S1 = ScTiles::G_S1;
    bf16_t* Pt = (bf16_t*)(smem + O_P) + wave * (16 * 64);
    float* bi = (float*)(smem + O_BI) + wave * 128;
    float* X = (float*)(smem + O_X);
    u32x4 rg[17];
    { const int u0 = min((int)blockIdx.x, 2111); sc_prefetch(p, unit_kind(u0), (u0 >> 1) / 132, (u0 >> 1) % 132, tid, rg); }
    for (int u = blockIdx.x; u < 2112; u += gridDim.x) {
        const int kind = unit_kind(u), r = u >> 1; const int h = r / 132, tt = r % 132; const int m0 = tt * 64, zh = z * 8 + h;
        __syncthreads();
        sc_store(smem, kind, tid, rg);
        f32x4 hv[8];
        float lf = 0.f, ig = 0.f;
        if (kind == 0) { lf = LF[(size_t)zh * NT + m0 + lane]; ig = IG[(size_t)zh * NT + m0 + lane]; }
        { const int un = min(u + (int)gridDim.x, 2111); sc_prefetch(p, unit_kind(un), (un >> 1) / 132, (un >> 1) % 132, tid, rg); }
        if (kind == 0) {
            float tot; const float pre = wave_incl_scan(lf, lane, tot); const float b = z ? tot - pre + lf : pre;
            bi[lane] = b; bi[64 + lane] = ig;
            __syncthreads();
            bf16x8_t qa[4];
#pragma unroll
            for (int ks = 0; ks < 4; ++ks) qa[ks] = *(const bf16x8_t*)(smem + O_Q + (t0 + lr) * 272 + (ks * 32 + 8 * lq) * 2);
            const f32x4 bt4 = *(const f32x4*)(bi + t0 + lq * 4);
#pragma unroll
            for (int nt = 0; nt < 4; ++nt) {
                f32x4 sacc = {0.f, 0.f, 0.f, 0.f};
#pragma unroll
                for (int ks = 0; ks < 4; ++ks) { const bf16x8_t kb = *(const bf16x8_t*)(smem + O_K + (nt * 16 + lr) * 272 + (ks * 32 + 8 * lq) * 2); sacc = MFMA16(qa[ks], kb, sacc); }
                const int sidx = nt * 16 + lr; const float bs = bi[sidx], is = bi[64 + sidx];
#pragma unroll
                for (int rg_ = 0; rg_ < 4; ++rg_) { const int t = t0 + lq * 4 + rg_; const bool keep = z ? (sidx >= t) : (sidx <= t);
                    const float val = keep ? sacc[rg_] * __expf(bt4[rg_] - bs + is) : 0.f; Pt[(lq * 4 + rg_) * 64 + sidx] = (bf16_t)f2bf(val); }
            }
            bf16x8_t pa[2];
#pragma unroll
            for (int ks = 0; ks < 2; ++ks) pa[ks] = *(const bf16x8_t*)(Pt + lr * 64 + ks * 32 + 8 * lq);
            const float e0 = __expf(bt4[0]), e1 = __expf(bt4[1]), e2 = __expf(bt4[2]), e3 = __expf(bt4[3]);
            const unsigned char* CT = smem + (z ? O_C1 : O_C0);
            f32x4 num[9];
#pragma unroll
            for (int nt = 0; nt < 9; ++nt) {
                f32x4 ai = {0.f, 0.f, 0.f, 0.f}, ac = {0.f, 0.f, 0.f, 0.f};
#pragma unroll
                for (int ks = 0; ks < 2; ++ks) { const bf16x8_t vb = *(const bf16x8_t*)(smem + O_V + (nt * 16 + lr) * 144 + (ks * 32 + 8 * lq) * 2); ai = MFMA16(pa[ks], vb, ai); }
#pragma unroll
                for (int ks = 0; ks < 4; ++ks) { const bf16x8_t cb = *(const bf16x8_t*)(CT + (nt * 16 + lr) * 272 + (ks * 32 + 8 * lq) * 2); ac = MFMA16(qa[ks], cb, ac); }
                num[nt] = (f32x4){ai[0] + e0 * ac[0], ai[1] + e1 * ac[1], ai[2] + e2 * ac[2], ai[3] + e3 * ac[3]};
            }
            f32x4 dn;
#pragma unroll
            for (int rg_ = 0; rg_ < 4; ++rg_) { const float d = __shfl(num[8][rg_], lane & 48); dn[rg_] = 1.f / fmaxf(fabsf(d), 1.f); }
#pragma unroll
            for (int nt = 0; nt < 8; ++nt) hv[nt] = num[nt] * dn;
        } else {
            __syncthreads();
            const unsigned char* Ql = smem + (z ? G_Q1 : G_Q0); const unsigned char* Kl = smem + (z ? G_K1 : G_K0); const unsigned char* Sl = smem + (z ? G_S1 : G_S0);
            bf16x8_t qa[2];
#pragma unroll
            for (int ks = 0; ks < 2; ++ks) qa[ks] = *(const bf16x8_t*)(Ql + (t0 + lr) * 144 + (ks * 32 + 8 * lq) * 2);
#pragma unroll
            for (int nt = 0; nt < 4; ++nt) {
                f32x4 sacc = {0.f, 0.f, 0.f, 0.f};
#pragma unroll
                for (int ks = 0; ks < 2; ++ks) { const bf16x8_t kb = *(const bf16x8_t*)(Kl + (nt * 16 + lr) * 144 + (ks * 32 + 8 * lq) * 2); sacc = MFMA16(qa[ks], kb, sacc); }
                const int sidx = nt * 16 + lr;
#pragma unroll
                for (int rg_ = 0; rg_ < 4; ++rg_) { const int t = t0 + lq * 4 + rg_; const bool keep = z ? (sidx >= t) : (sidx <= t); Pt[(lq * 4 + rg_) * 64 + sidx] = (bf16_t)f2bf(keep ? sacc[rg_] : 0.f); }
            }
            bf16x8_t pa[2];
#pragma unroll
            for (int ks = 0; ks < 2; ++ks) pa[ks] = *(const bf16x8_t*)(Pt + lr * 64 + ks * 32 + 8 * lq);
#pragma unroll
            for (int nt = 0; nt < 8; ++nt) {
                f32x4 acc = {0.f, 0.f, 0.f, 0.f};
#pragma unroll
                for (int ks = 0; ks < 2; ++ks) { const bf16x8_t vb = *(const bf16x8_t*)(smem + G_V + (nt * 16 + lr) * 144 + (ks * 32 + 8 * lq) * 2); acc = MFMA16(pa[ks], vb, acc); }
#pragma unroll
                for (int ks = 0; ks < 2; ++ks) { const bf16x8_t sb = *(const bf16x8_t*)(Sl + (nt * 16 + lr) * 144 + (ks * 32 + 8 * lq) * 2); acc = MFMA16(qa[ks], sb, acc); }
                hv[nt] = acc;
            }
        }
        __syncthreads();
        if (z == 1) {
#pragma unroll
            for (int nt = 0; nt < 8; ++nt)
#pragma unroll
                for (int rg = 0; rg < 4; ++rg) X[(mt * 16 + lq * 4 + rg) * 128 + nt * 16 + lr] = hv[nt][rg];
        }
        __syncthreads();
        if (z == 0) {
            f32x4 ss = {0.f, 0.f, 0.f, 0.f};
#pragma unroll
            for (int nt = 0; nt < 8; ++nt) {
#pragma unroll
                for (int rg = 0; rg < 4; ++rg) hv[nt][rg] += X[(mt * 16 + lq * 4 + rg) * 128 + nt * 16 + lr];
                ss += hv[nt] * hv[nt]; }
#pragma unroll
            for (int rg = 0; rg < 4; ++rg) { float v = ss[rg]; v += __shfl_xor(v, 1); v += __shfl_xor(v, 2); v += __shfl_xor(v, 4); v += __shfl_xor(v, 8); ss[rg] = rsqrtf(v * (1.f / 128.f) + 1e-6f); }
#pragma unroll
            for (int nt = 0; nt < 8; ++nt)
#pragma unroll
                for (int rg = 0; rg < 4; ++rg) X[(mt * 16 + lq * 4 + rg) * 128 + nt * 16 + lr] = hv[nt][rg] * ss[rg];
        }
        __syncthreads();
        {
            const int gcol = kind == 0 ? CA_O : CB_R; const int ycol = kind == 0 ? 0 : 1024; const float* hg = p.ab_head_g + kind * 128;
#pragma unroll
            for (int i = 0; i < 2; ++i) { const int e = tid + NTHR * i; const int row = e >> 4, c = e & 15;
                const f32x4 x0 = *(const f32x4*)(X + row * 128 + c * 8), x1 = *(const f32x4*)(X + row * 128 + c * 8 + 4);
                const f32x4 g0 = *(const f32x4*)(hg + c * 8), g1 = *(const f32x4*)(hg + c * 8 + 4);
                const u32x4 gt = *(const u32x4*)(PAB + (size_t)(m0 + row) * PAB_LD + gcol + h * 128 + c * 8);
                float gv[8] = {bfl(gt.x), bfh(gt.x), bfl(gt.y), bfh(gt.y), bfl(gt.z), bfh(gt.z), bfl(gt.w), bfh(gt.w)};
#pragma unroll
                for (int j = 0; j < 8; ++j) gv[j] = kind == 0 ? sigmoidf_(gv[j]) : siluf(gv[j]);
                u32x4 ov; ov.x = pk2(x0[0] * g0[0] * gv[0], x0[1] * g0[1] * gv[1]); ov.y = pk2(x0[2] * g0[2] * gv[2], x0[3] * g0[3] * gv[3]);
                ov.z = pk2(x1[0] * g1[0] * gv[4], x1[1] * g1[1] * gv[5]); ov.w = pk2(x1[2] * g1[2] * gv[6], x1[3] * g1[3] * gv[7]);
                *(u32x4*)(YM + (size_t)(m0 + row) * DM + ycol + h * 128 + c * 8) = ov; }
        }
    }
}

__device__ __forceinline__ u32 ord_key(float s) { const u32 u = __float_as_uint(s); return (u & 0x80000000u) ? ~u : (u | 0x80000000u); }
__device__ __forceinline__ float ord_val(u32 o) { const u32 u = (o & 0x80000000u) ? (o ^ 0x80000000u) : ~o; return __uint_as_float(u); }
template <int N> __device__ __forceinline__ u32 row_ror(u32 v) { return (u32)__builtin_amdgcn_update_dpp(0, (int)v, 0x120 | N, 0xF, 0xF, false); }
__device__ __forceinline__ u32 umax(u32 a, u32 b) { return a > b ? a : b; }
__device__ __forceinline__ u32 umin(u32 a, u32 b) { return a < b ? a : b; }
__device__ __forceinline__ u32 row_allmax(u32 v) { v = umax(v, row_ror<8>(v)); v = umax(v, row_ror<4>(v)); v = umax(v, row_ror<2>(v)); v = umax(v, row_ror<1>(v)); return v; }
#define CEX(i, j) { const u32 hi_ = umax(k[i], k[j]), lo_ = umin(k[i], k[j]); k[i] = hi_; k[j] = lo_; }
__device__ __forceinline__ void ph_route(const Params& p, int l, int nrows, unsigned char* smem) {
    const bf16_t* QP = (const bf16_t*)(p.ws + OFF_QP); const bf16_t* KEYSB = (const bf16_t*)(p.ws + OFF_KEYSB); int* EIDX = (int*)(p.ws + OFF_EIDX); float* EG = (float*)(p.ws + OFF_EG);
    const int tid = TID(), lane = tid & 63, wave = tid >> 6, lr = lane & 15, lq = lane >> 4;
    float* SC = (float*)smem;
    float* TOPV = (float*)(smem + 65536);
    int* TOPI = (int*)(smem + 65536 + 8192);
    unsigned char* KL = smem + 81920;
    int cur_head = -1;
    int ca[4], cb[4];
#pragma unroll
    for (int q = 0; q < 4; ++q) { int c = lr + 16 * q, a_ = 0, off = 0;
        for (int a2 = 0; a2 < 16; ++a2) { const int nb = 16 / (a2 + 1); if (c >= off && c < off + nb) { a_ = a2; break; } off += nb; }
        ca[q] = a_; cb[q] = c - off; if (c >= 50) { ca[q] = 0; cb[q] = 0; } }
    const bool c3ok = (lr + 48) < 50;
    const int ntile = nrows / 64;
    for (int u = blockIdx.x; u < ntile * 8; u += gridDim.x) {
        const int tt = u >> 3, head = u & 7; const int m0 = tt * 64;
        if (head != cur_head) {
            __syncthreads();
#pragma unroll
            for (int i = 0; i < 8; ++i) { const int pc = tid + NTHR * i; const int row = pc >> 4, c = pc & 15;
                *(u32x4*)(KL + row * 272 + c * 16) = *(const u32x4*)(KEYSB + ((size_t)(l * 8 + head) * 256 + row) * 128 + c * 8); }
            cur_head = head;
            __syncthreads();
        }
        {
            const int z = wave >> 2, mt = wave & 3;
            bf16x8_t qa[4];
#pragma unroll
            for (int ks = 0; ks < 4; ++ks) qa[ks] = ld8(QP + (size_t)(m0 + mt * 16 + lr) * DM + head * 256 + z * 128 + ks * 32 + 8 * lq);
            const unsigned char* kb = KL + (z * 128) * 272;
#pragma unroll
            for (int nt = 0; nt < 8; ++nt) { f32x4 acc = {0.f, 0.f, 0.f, 0.f};
#pragma unroll
                for (int ks = 0; ks < 4; ++ks) { const bf16x8_t bb = *(const bf16x8_t*)(kb + (nt * 16 + lr) * 272 + (ks * 32 + 8 * lq) * 2); acc = MFMA16(qa[ks], bb, acc); }
#pragma unroll
                for (int rg = 0; rg < 4; ++rg) SC[(z * 64 + mt * 16 + lq * 4 + rg) * 128 + nt * 16 + lr] = acc[rg]; }
        }
        __syncthreads();
        for (int rd = 0; rd < 4; ++rd) {
            const int pi = rd * 32 + wave * 4 + lq; const int z = pi >> 6, t = pi & 63;
            const f32x4 s0 = *(const f32x4*)(SC + (z * 64 + t) * 128 + lr * 8), s1 = *(const f32x4*)(SC + (z * 64 + t) * 128 + lr * 8 + 4);
            u32 k[8];
            k[0] = (ord_key(s0.x) & ~0x7fu) | (u32)(127 - (lr * 8 + 0)); k[1] = (ord_key(s0.y) & ~0x7fu) | (u32)(127 - (lr * 8 + 1));
            k[2] = (ord_key(s0.z) & ~0x7fu) | (u32)(127 - (lr * 8 + 2)); k[3] = (ord_key(s0.w) & ~0x7fu) | (u32)(127 - (lr * 8 + 3));
            k[4] = (ord_key(s1.x) & ~0x7fu) | (u32)(127 - (lr * 8 + 4)); k[5] = (ord_key(s1.y) & ~0x7fu) | (u32)(127 - (lr * 8 + 5));
            k[6] = (ord_key(s1.z) & ~0x7fu) | (u32)(127 - (lr * 8 + 6)); k[7] = (ord_key(s1.w) & ~0x7fu) | (u32)(127 - (lr * 8 + 7));
            CEX(0, 1) CEX(2, 3) CEX(4, 5) CEX(6, 7)  CEX(0, 2) CEX(1, 3) CEX(4, 6) CEX(5, 7)  CEX(1, 2) CEX(5, 6) CEX(0, 4) CEX(3, 7)
            CEX(1, 5) CEX(2, 6)  CEX(1, 4) CEX(3, 6)  CEX(2, 4) CEX(3, 5)  CEX(3, 4)
            u32 sel = 0u;
#pragma unroll
            for (int r = 0; r < 16; ++r) {
                const u32 bm = row_allmax(k[0]);
                if (k[0] == bm) { k[0] = k[1]; k[1] = k[2]; k[2] = k[3]; k[3] = k[4]; k[4] = k[5]; k[5] = k[6]; k[6] = k[7]; k[7] = 0u; }
                if (lr == r) sel = bm;
            }
            TOPV[(t * 2 + z) * 16 + lr] = ord_val(sel & ~0x7fu); TOPI[(t * 2 + z) * 16 + lr] = 127 - (int)(sel & 0x7fu);
        }
        __syncthreads();
        for (int rd = 0; rd < 2; ++rd) {
            const int t = rd * 32 + wave * 4 + lq;
            const float* tv = TOPV + t * 32; const int* ti = TOPI + t * 32;
            u32 k[4];
#pragma unroll
            for (int q = 0; q < 4; ++q) k[q] = (ord_key(tv[ca[q]] + tv[16 + cb[q]]) & ~0xffu) | (u32)(255 - (ca[q] * 16 + cb[q]));
            if (!c3ok) k[3] = 0u;
            u32 sel = 0u;
#pragma unroll
            for (int r = 0; r < 16; ++r) {
                const u32 bm = row_allmax(umax(umax(k[0], k[1]), umax(k[2], k[3])));
#pragma unroll
                for (int q = 0; q < 4; ++q) if (k[q] == bm) k[q] = 0u;
                if (lr == r) sel = bm;
            }
            const int cj = 255 - (int)(sel & 0xffu); const int ia = ti[(cj >> 4) & 15], ib = ti[16 + (cj & 15)];
            const float bv = ord_val(sel & ~0xffu); const float top = ord_val(row_allmax(sel) & ~0xffu);
            const float ex = __expf(bv - top);
            float sm = ex;
            sm += __uint_as_float(row_ror<8>(__float_as_uint(sm))); sm += __uint_as_float(row_ror<4>(__float_as_uint(sm)));
            sm += __uint_as_float(row_ror<2>(__float_as_uint(sm))); sm += __uint_as_float(row_ror<1>(__float_as_uint(sm)));
            EIDX[(size_t)(m0 + t) * 128 + head * 16 + lr] = ia * 128 + ib; EG[(size_t)(m0 + t) * 128 + head * 16 + lr] = ex / sm;
        }
        __syncthreads();
    }
}
#undef CEX

__device__ __forceinline__ float ub(u32 w, int k) { return (float)((w >> (8 * k)) & 0xffu); }
typedef float f32x2_t __attribute__((ext_vector_type(2)));
__device__ __forceinline__ float row_allsum_f(float v) {
    v += __uint_as_float(row_ror<8>(__float_as_uint(v))); v += __uint_as_float(row_ror<4>(__float_as_uint(v)));
    v += __uint_as_float(row_ror<2>(__float_as_uint(v))); v += __uint_as_float(row_ror<1>(__float_as_uint(v))); return v; }
__device__ __forceinline__ float gelu_fast(float x) { return x * frcp(1.f + __expf(-1.5957691216057308f * (x + 0.044715f * x * x * x))); }
__device__ __forceinline__ void ph_experts(const Params& p, int l, int nrows, const float* x_lat, const float* x_ctx, float* o_lat, float* o_ctx, unsigned char* smem, bool fuse_norm, int abl = 0) {
    const unsigned char* HQ = p.ws + OFF_HQ; const float* HQS = (const float*)(p.ws + OFF_HQS); const int* EIDX = (const int*)(p.ws + OFF_EIDX); const float* EG = (const float*)(p.ws + OFF_EG);
    const unsigned char* TU = p.ws + (l == 0 ? OFF_TU0 : OFF_TU1); const unsigned char* TV = p.ws + (l == 0 ? OFF_TV0 : OFF_TV1);
    const bf16_t* TUS = (const bf16_t*)(TU + 32 * MiB); const bf16_t* TVS = (const bf16_t*)(TV + 32 * MiB);
    const float* modv = (const float*)(p.ws + OFF_MODV);
    float* part = (float*)smem;
    const int tid = TID(), lane = tid & 63, wave = __builtin_amdgcn_readfirstlane(tid >> 6);
    const int bid = blockIdx.x, G = gridDim.x;
    const int ntok = bid < nrows ? (nrows - bid + G - 1) / G : 0; const int NGp = ntok * 4;
    u32x4 uq[3][4], vq[3][4]; float su[3][4], sv[3][4], gw[3][4];
    u32x4 hnext[2]; float hsnext = 0.f;
    int hqe[4], hqo[4]; float hscale = 0.f, hsum8 = 0.f;
    f32x2_t acc[16]; float wtot = 0.f;
#pragma unroll
    for (int e = 0; e < 16; ++e) acc[e] = (f32x2_t){0.f, 0.f};
#define LOADG(B, gidx) do { const int m_ = bid + ((gidx) >> 2) * G; const int* ei_ = EIDX + (size_t)m_ * 128 + wave * 16 + ((gidx) & 3) * 4; const float* eg_ = EG + (size_t)m_ * 128 + wave * 16 + ((gidx) & 3) * 4; \
        _Pragma("unroll") for (int i = 0; i < 4; ++i) { const int e_ = ei_[i]; gw[B][i] = eg_[i]; \
            if (abl == 1) { su[B][i] = 1.f; sv[B][i] = 1.f; vq[B][i] = (u32x4){(u32)e_, (u32)lane, 3u, 4u}; uq[B][i] = vq[B][i]; } \
            else { su[B][i] = bf2f(TUS[(size_t)e_ * 64 + lane]); sv[B][i] = bf2f(TVS[(size_t)e_ * 64 + lane]); uq[B][i] = *(const u32x4*)(TU + (size_t)e_ * 1024 + lane * 16); vq[B][i] = *(const u32x4*)(TV + (size_t)e_ * 1024 + lane * 16); } } } while (0)
#define LOADH(t_) do { const int m_ = bid + (t_) * G; hnext[0] = *(const u32x4*)(HQ + (size_t)m_ * DM + lane * 32); hnext[1] = *(const u32x4*)(HQ + (size_t)m_ * DM + lane * 32 + 16); hsnext = HQS[m_]; } while (0)
#define BODY(B, gidx) do { \
        if (((gidx) & 3) == 0) {   \
            int hs_ = 0; hscale = hsnext; \
            _Pragma("unroll") for (int d = 0; d < 4; ++d) { const u32 d0_ = hnext[d >> 1][(d & 1) * 2], d1_ = hnext[d >> 1][(d & 1) * 2 + 1]; \
                hqe[d] = (int)__builtin_amdgcn_perm(d1_, d0_, 0x06040200u); hqo[d] = (int)__builtin_amdgcn_perm(d1_, d0_, 0x07050301u); \
                hs_ = __builtin_amdgcn_sdot4((int)d0_, 0x01010101, hs_, false); hs_ = __builtin_amdgcn_sdot4((int)d1_, 0x01010101, hs_, false); } \
            hsum8 = (float)(8 * hs_); \
            _Pragma("unroll") for (int e = 0; e < 16; ++e) acc[e] = (f32x2_t){0.f, 0.f}; wtot = 0.f; \
            if ((((gidx) >> 2) + 1) < ntok) LOADH(((gidx) >> 2) + 1); } \
        if ((gidx) + 2 < NGp) LOADG(((B) + 2) % 3, (gidx) + 2); \
        if (abl == 2) { _Pragma("unroll") for (int i = 0; i < 4; ++i) { const u32x4 t_ = uq[B][i] ^ vq[B][i]; acc[i][0] += __uint_as_float((t_.x ^ t_.y ^ t_.z ^ t_.w) & 0x3fffffu) * su[B][i] * sv[B][i]; } } \
        else { \
        float zl[4]; \
        _Pragma("unroll") for (int i = 0; i < 4; ++i) { int d_ = 0; \
            _Pragma("unroll") for (int d = 0; d < 4; ++d) { u32 lo = uq[B][i][d] & 0x0f0f0f0fu, hi = (uq[B][i][d] >> 4) & 0x0f0f0f0fu; asm volatile("" : "+v"(lo), "+v"(hi)); d_ = __builtin_amdgcn_sdot4((int)lo, hqe[d], d_, false); d_ = __builtin_amdgcn_sdot4((int)hi, hqo[d], d_, false); } \
            const float zz_ = row_allsum_f(su[B][i] * ((float)d_ - hsum8)); \
            zl[i] = __int_as_float(__builtin_amdgcn_readlane(__float_as_int(zz_), 0)) + __int_as_float(__builtin_amdgcn_readlane(__float_as_int(zz_), 16)) \
                    + __int_as_float(__builtin_amdgcn_readlane(__float_as_int(zz_), 32)) + __int_as_float(__builtin_amdgcn_readlane(__float_as_int(zz_), 48)); } \
        _Pragma("unroll") for (int i = 0; i < 4; ++i) { \
            const float w = gw[B][i] * gelu_fast(zl[i] * hscale) * sv[B][i]; wtot += w; const f32x2_t w2 = {w, w}; \
            _Pragma("unroll") for (int d = 0; d < 4; ++d) { u32 lo = vq[B][i][d] & 0x0f0f0f0fu, hi = (vq[B][i][d] >> 4) & 0x0f0f0f0fu; asm volatile("" : "+v"(lo), "+v"(hi)); \
                _Pragma("unroll") for (int k = 0; k < 4; ++k) { const f32x2_t val = {ub(lo, k), ub(hi, k)}; acc[d * 4 + k] += w2 * val; } } } \
        } \
        if (((gidx) & 3) == 3) {   \
            const int m = bid + ((gidx) >> 2) * G; const float wt8 = wtot * 8.f; \
            { float* d = part + wave * 2048 + lane * 4; \
              _Pragma("unroll") for (int q = 0; q < 8; ++q) *(f32x4*)(d + q * 256) = (f32x4){acc[q * 2][0] - wt8, acc[q * 2][1] - wt8, acc[q * 2 + 1][0] - wt8, acc[q * 2 + 1][1] - wt8}; } \
            __syncthreads(); \
            f32x4 xv; const bool isc = m >= NL; \
            { f32x4 sm = {0.f, 0.f, 0.f, 0.f}; \
              _Pragma("unroll") for (int w_ = 0; w_ < 8; ++w_) sm += *(const f32x4*)(part + w_ * 2048 + tid * 4); \
              const float* xr = isc ? x_ctx + (size_t)(m - NL) * DM : x_lat + (size_t)m * DM; float* orow = isc ? o_ctx + (size_t)(m - NL) * DM : o_lat + (size_t)m * DM; \
              const f32x4 gate = *(const f32x4*)(modv + (size_t)(l * 2 + (isc ? 1 : 0)) * 12288 + 5 * 2048 + tid * 4); \
              xv = *(const f32x4*)(xr + tid * 4); xv += gate * sm; *(f32x4*)(orow + tid * 4) = xv; } \
            if (fuse_norm) {   \
                const float* mv = modv + (size_t)((l + 1) * 2 + (isc ? 1 : 0)) * 12288; \
                const f32x4 gg = *(const f32x4*)(p.norm_g + (size_t)((l + 1) * 2) * 2048 + tid * 4), sh = *(const f32x4*)(mv + tid * 4), sc = *(const f32x4*)(mv + 2048 + tid * 4); \
                const f32x4 xg = xv * gg * (sc + 1.f); \
                float ss = xv.x * xv.x + xv.y * xv.y + xv.z * xv.z + xv.w * xv.w; ss = wave_sum(ss); \
                const float m1 = wave_max(fmaxf(fmaxf(fabsf(xg.x), fabsf(xg.y)), fmaxf(fabsf(xg.z), fabsf(xg.w)))), m2 = wave_max(fmaxf(fmaxf(fabsf(sh.x), fabsf(sh.y)), fmaxf(fabsf(sh.z), fabsf(sh.w)))); \
                float* red = (float*)(smem + 65536); if (lane == 0) { red[wave] = ss; red[8 + wave] = m1; red[16 + wave] = m2; } \
                __syncthreads(); \
                const float tot = ((red[0] + red[1]) + (red[2] + red[3])) + ((red[4] + red[5]) + (red[6] + red[7])); \
                const float M1 = fmaxf(fmaxf(fmaxf(red[8], red[9]), fmaxf(red[10], red[11])), fmaxf(fmaxf(red[12], red[13]), fmaxf(red[14], red[15]))); \
                const float M2 = fmaxf(fmaxf(fmaxf(red[16], red[17]), fmaxf(red[18], red[19])), fmaxf(fmaxf(red[20], red[21]), fmaxf(red[22], red[23]))); \
                const float r = rsqrtf(tot * (1.f / 2048.f) + 1e-6f); \
                const float bnd = fmaxf(r * M1 + M2, 1e-30f); const float inv8 = 127.f / bnd; \
                const f32x4 y = xg * r + sh; \
                const u32 q8 = ((u32)((int)rintf(y.x * inv8)) & 0xffu) | (((u32)((int)rintf(y.y * inv8)) & 0xffu) << 8) | (((u32)((int)rintf(y.z * inv8)) & 0xffu) << 16) | (((u32)((int)rintf(y.w * inv8)) & 0xffu) << 24); \
                *(u32*)(p.ws + OFF_H8 + (size_t)m * DM + tid * 4) = q8; \
                if (tid == 0) ((float*)(p.ws + OFF_HS8))[m] = bnd * (1.f / 127.f); \
                __syncthreads(); \
            } else __syncthreads(); } \
    } while (0)
    if (ntok > 0) { LOADH(0); LOADG(0, 0); LOADG(1, 1); }
    for (int gi = 0; gi < NGp; gi += 3) {
        BODY(0, gi);
        if (gi + 1 < NGp) BODY(1, gi + 1);
        if (gi + 2 < NGp) BODY(2, gi + 2);
    }
#undef LOADG
#undef LOADH
#undef BODY
}

__device__ __forceinline__ void ph_prep_cd(const Params& p, unsigned char* smem) {
    const bf16_t* PCD = (const bf16_t*)(p.ws + OFF_PAB);
    bf16_t* CQ = (bf16_t*)(p.ws + OFF_CQ); bf16_t* CK = (bf16_t*)(p.ws + OFF_CK); bf16_t* DQ = (bf16_t*)(p.ws + OFF_DQ); bf16_t* DK = (bf16_t*)(p.ws + OFF_DK);
    {
        bf16_t* CVT = (bf16_t*)(p.ws + OFF_CVT); bf16_t* DVT = (bf16_t*)(p.ws + OFF_DVT);
        bf16_t* tV = (bf16_t*)smem; const int tid = TID();
        for (int u = blockIdx.x; u < 132 * 10; u += gridDim.x) {
            const int tt = u / 10, vh = u % 10; const int m0 = tt * 64; const int col = vh < 8 ? 1024 + vh * 128 : 2304 + (vh - 8) * 128;
            bf16_t* dst = vh < 8 ? CVT + (size_t)vh * 128 * NT : DVT + (size_t)(vh - 8) * 128 * NT;
            for (int e = tid; e < 64 * 16; e += NTHR) { const int tau = e >> 4, c8 = e & 15; *(u32x4*)(tV + tau * 128 + c8 * 8) = *(const u32x4*)(PCD + (size_t)(m0 + tau) * PCD_LD + col + c8 * 8); }
            __syncthreads();
            for (int e = tid; e < 128 * 8; e += NTHR) { const int d = e >> 3, c8 = e & 7; u32 tv[8];
#pragma unroll
                for (int j = 0; j < 8; ++j) tv[j] = tV[(c8 * 8 + j) * 128 + d];
                u32x4 ov; ov.x = tv[0] | (tv[1] << 16); ov.y = tv[2] | (tv[3] << 16); ov.z = tv[4] | (tv[5] << 16); ov.w = tv[6] | (tv[7] << 16);
                *(u32x4*)(dst + (size_t)d * NT + m0 + c8 * 8) = ov; }
            __syncthreads();
        }
    }
    const int lane = TID() & 63, wave = TID() >> 6, lr = lane & 15, lq = lane >> 4;
    const int i0 = 4 * (lr & 7) + 64 * (lr >> 3);
    float fr[4];
#pragma unroll
    for (int e = 0; e < 4; ++e) fr[e] = __powf(10000.f, -(float)(4 * (lr & 7) + e) * (1.f / 32.f));
    for (int jw = blockIdx.x * 8 + wave; jw < NT * 26 / 4; jw += gridDim.x * 8) {
        const int j = jw * 4 + lq; const int m = j / 26, s_ = j % 26;
        const bool skip = m >= NL && (s_ < 8 || (s_ >= 16 && s_ < 24));
        int col, gi; bool rope; float scale; bf16_t* dst;
        if (s_ < 8) { col = 2560 + s_ * 128; gi = 0; rope = false; scale = 0.08838834764831845f * 1.4426950408889634f; dst = CQ + ((size_t)s_ * NL + m) * 128; }
        else if (s_ < 16) { col = (s_ - 8) * 128; gi = 1; rope = false; scale = 1.f; dst = CK + ((size_t)(s_ - 8) * NT + m) * 128; }
        else if (s_ < 24) { col = 3584 + (s_ - 16) * 128; gi = 2; rope = true; scale = 0.08838834764831845f * 1.4426950408889634f; dst = DQ + ((size_t)(s_ - 16) * NL + m) * 128; }
        else { col = 2048 + (s_ - 24) * 128; gi = 3; rope = m < NL; scale = 1.f; dst = DK + ((size_t)(s_ - 24) * NT + m) * 128; }
        const bf16_t* src = PCD + (size_t)m * PCD_LD + col;
        const u32x2 lo2 = *(const u32x2*)(src + i0), hi2 = *(const u32x2*)(src + i0 + 32);
        float x[4] = {bfl(lo2.x), bfh(lo2.x), bfl(lo2.y), bfh(lo2.y)}, y[4] = {bfl(hi2.x), bfh(hi2.x), bfl(hi2.y), bfh(hi2.y)};
        float ss = x[0] * x[0] + x[1] * x[1] + x[2] * x[2] + x[3] * x[3] + y[0] * y[0] + y[1] * y[1] + y[2] * y[2] + y[3] * y[3];
        ss += __shfl_xor(ss, 1); ss += __shfl_xor(ss, 2); ss += __shfl_xor(ss, 4); ss += __shfl_xor(ss, 8);
        const float r = rsqrtf(ss * (1.f / 128.f) + 1e-6f);
        const f32x4 g0 = *(const f32x4*)(p.cd_qk_g + gi * 128 + i0), g1 = *(const f32x4*)(p.cd_qk_g + gi * 128 + i0 + 32);
        const float pos = (float)((lr < 8) ? (m >> 6) : (m & 63));
#pragma unroll
        for (int e = 0; e < 4; ++e) { float a = x[e] * r * g0[e], b = y[e] * r * g1[e];
            if (rope) { const float ang = pos * fr[e]; const float cs = cosf(ang), sn = sinf(ang); const float a2 = a * cs - b * sn, b2 = a * sn + b * cs; a = a2; b = b2; }
            x[e] = a * scale; y[e] = b * scale; }
        if (!skip) { u32x2 o0, o1; o0.x = pk2(x[0], x[1]); o0.y = pk2(x[2], x[3]); o1.x = pk2(y[0], y[1]); o1.y = pk2(y[2], y[3]);
            *(u32x2*)(dst + i0) = o0; *(u32x2*)(dst + i0 + 32) = o1; }
    }
}

__device__ __forceinline__ void ph_attn(const Params& p, unsigned char* smem) {
    const bf16_t* CQ = (const bf16_t*)(p.ws + OFF_CQ); const bf16_t* CK = (const bf16_t*)(p.ws + OFF_CK); const bf16_t* DQ = (const bf16_t*)(p.ws + OFF_DQ); const bf16_t* DK = (const bf16_t*)(p.ws + OFF_DK);
    const bf16_t* CVT = (const bf16_t*)(p.ws + OFF_CVT); const bf16_t* DVT = (const bf16_t*)(p.ws + OFF_DVT);
    bf16_t* YM = (bf16_t*)(p.ws + OFF_YM);
    const int tid = TID(), lane = tid & 63, wave = tid >> 6, lr = lane & 15, lq = lane >> 4, mt = wave & 3, hl = wave >> 2;
    constexpr int KT_B = 64 * 272, VT_B = 128 * 144, SLOT_B = KT_B + VT_B;
    constexpr int BUF_B = 2 * SLOT_B;
    bf16_t* Pt = (bf16_t*)(smem + 2 * BUF_B) + wave * (16 * 64);
    float* rp = (float*)(smem + 2 * BUF_B + 16384);
    for (int u = blockIdx.x; u < 1024; u += gridDim.x) {
        const int kind = unit_kind(u), r = u >> 1, hp = r & 3, qt = r >> 2; const int h = hp * 2 + hl;
        const int q0 = qt * 64 + mt * 16;
        const bf16_t* Qb = kind == 0 ? CQ + ((size_t)h * NL + q0) * 128 : DQ + ((size_t)h * NL + q0) * 128;
        const bf16_t* Ks0 = kind == 0 ? CK + (size_t)(hp * 2) * NT * 128 : DK + (size_t)(hp >> 1) * NT * 128;
        const bf16_t* Vs0 = kind == 0 ? CVT + (size_t)(hp * 2) * 128 * NT : DVT + (size_t)(hp >> 1) * 128 * NT;
        const int npc = kind == 0 ? 8 : 4;
        const int slot = kind == 0 ? hl : 0;
        bf16x8_t qa[4];
#pragma unroll
        for (int ks = 0; ks < 4; ++ks) qa[ks] = ld8(Qb + (size_t)lr * 128 + ks * 32 + 8 * lq);
        f32x4 o[8];
#pragma unroll
        for (int i = 0; i < 8; ++i) o[i] = (f32x4){0.f, 0.f, 0.f, 0.f};
        f32x4 mrow = {-1e30f, -1e30f, -1e30f, -1e30f}, lrow = {0.f, 0.f, 0.f, 0.f};
        const int base1 = lr - lq * 4;
        int lo4[4];
#pragma unroll
        for (int rg = 0; rg < 4; ++rg) { const int cq = mt * 16 + lq * 4 + rg; lo4[rg] = min(max(cq - 8, 0), 48) - cq; }
        if (kind == 0) { *(u32x4*)(Pt + lane * 16) = (u32x4){0u, 0u, 0u, 0u}; *(u32x4*)(Pt + lane * 16 + 8) = (u32x4){0u, 0u, 0u, 0u}; }
        const int rs = min(max(qt - 4, 0), 120);
        const int nloc = kind == 0 ? 8 : 5;
        int bfirst = 0, blast = kind == 0 ? 11 : 8;
        if (kind == 1) { if (qt < 2) bfirst = 2 - qt; }
#define KEY0(b) ((b) < nloc ? (kind == 0 ? (rs + (b)) * 64 : (qt - 2 + (b)) * 64) : NL + ((b) - nloc) * 64)
#define BVALID(b) (!(kind == 1 && (b) < nloc && (qt - 2 + (b)) > 127))
        u32x4 st[8];
#define PREFETCH(b) do { const int k0_ = KEY0(b); _Pragma("unroll") for (int i = 0; i < 8; ++i) if (i < npc) { \
            const int pc = tid + NTHR * (i & 1); \
            if (kind == 0) { const int sl = (i >> 1) & 1; if (i < 4) st[i] = *(const u32x4*)(Ks0 + (size_t)sl * NT * 128 + (size_t)(k0_ + (pc >> 4)) * 128 + (pc & 15) * 8); \
                             else st[i] = *(const u32x4*)(Vs0 + (size_t)sl * 128 * NT + (size_t)(pc >> 3) * NT + k0_ + (pc & 7) * 8); } \
            else { if (i < 2) st[i] = *(const u32x4*)(Ks0 + (size_t)(k0_ + (pc >> 4)) * 128 + (pc & 15) * 8); else st[i] = *(const u32x4*)(Vs0 + (size_t)(pc >> 3) * NT + k0_ + (pc & 7) * 8); } } } while (0)
#define STAGEW(bufo) do { unsigned char* sb_ = smem + (bufo); _Pragma("unroll") for (int i = 0; i < 8; ++i) if (i < npc) { const int pc = tid + NTHR * (i & 1); \
            if (kind == 0) { const int sl = (i >> 1) & 1; if (i < 4) *(u32x4*)(sb_ + sl * SLOT_B + (pc >> 4) * 272 + (pc & 15) * 16) = st[i]; else *(u32x4*)(sb_ + sl * SLOT_B + KT_B + (pc >> 3) * 144 + (pc & 7) * 16) = st[i]; } \
            else { if (i < 2) *(u32x4*)(sb_ + (pc >> 4) * 272 + (pc & 15) * 16) = st[i]; else *(u32x4*)(sb_ + KT_B + (pc >> 3) * 144 + (pc & 7) * 16) = st[i]; } } } while (0)
        PREFETCH(bfirst);
        __syncthreads();
        if (kind == 0) for (int e = tid; e < 930; e += NTHR) rp[e] = p.cd_rpb[(size_t)hp * 930 + e] * 1.4426950408889634f;
        STAGEW(0);
        __syncthreads();
        { int bn = bfirst + 1; while (bn <= blast && !BVALID(bn)) ++bn; if (bn <= blast) PREFETCH(bn); }
        int cnt = 0;
        for (int b = bfirst; b <= blast; ++b) {
            if (!BVALID(b)) continue;
            const unsigned char* Kl = smem + (cnt & 1) * BUF_B + slot * SLOT_B; const unsigned char* Vl = Kl + KT_B;
            const bool loc = b < nloc; const int key0 = KEY0(b);
#define ATT_TAIL(NT_, cb) do { \
            f32x4 mx; \
            _Pragma("unroll") for (int rg = 0; rg < 4; ++rg) { float m = sv[0][rg]; _Pragma("unroll") for (int t = 1; t < NT_; ++t) m = fmaxf(m, sv[t][rg]); \
                m = fmaxf(m, __uint_as_float(row_ror<8>(__float_as_uint(m)))); m = fmaxf(m, __uint_as_float(row_ror<4>(__float_as_uint(m)))); m = fmaxf(m, __uint_as_float(row_ror<2>(__float_as_uint(m)))); m = fmaxf(m, __uint_as_float(row_ror<1>(__float_as_uint(m)))); mx[rg] = fmaxf(m, mrow[rg]); } \
            f32x4 corr; \
            _Pragma("unroll") for (int rg = 0; rg < 4; ++rg) { corr[rg] = __builtin_amdgcn_exp2f(mrow[rg] - mx[rg]); mrow[rg] = mx[rg]; } \
            lrow *= corr; \
            _Pragma("unroll") for (int i = 0; i < 8; ++i) o[i] *= corr; \
            _Pragma("unroll") for (int t = 0; t < NT_; ++t) { float pv[4]; \
                _Pragma("unroll") for (int rg = 0; rg < 4; ++rg) { pv[rg] = __builtin_amdgcn_exp2f(sv[t][rg] - mx[rg]); lrow[rg] += pv[rg]; } \
                const u32 p01 = pk2(pv[0], pv[1]), p23 = pk2(pv[2], pv[3]); bf16_t* pp = Pt + (lq * 4) * 64 + ((cb) + t) * 16 + lr; \
                pp[0] = (bf16_t)(p01 & 0xffffu); pp[64] = (bf16_t)(p01 >> 16); pp[128] = (bf16_t)(p23 & 0xffffu); pp[192] = (bf16_t)(p23 >> 16); } \
            bf16x8_t pa[2]; \
            _Pragma("unroll") for (int ks = 0; ks < 2; ++ks) pa[ks] = *(const bf16x8_t*)(Pt + lr * 64 + ks * 32 + 8 * lq); \
            _Pragma("unroll") for (int ks = 0; ks < 2; ++ks) { \
                _Pragma("unroll") for (int i = 0; i < 8; ++i) { const bf16x8_t vb = *(const bf16x8_t*)(Vl + (i * 16 + lr) * 144 + (ks * 32 + 8 * lq) * 2); o[i] = MFMA16(pa[ks], vb, o[i]); } } \
            } while (0)
            if (loc && kind == 0) {
                const int k0 = min(max(mt * 16 - 8, 0), 32);
                f32x4 sv[2];
#pragma unroll
                for (int t = 0; t < 2; ++t) { sv[t] = (f32x4){0.f, 0.f, 0.f, 0.f};
#pragma unroll
                    for (int ks = 0; ks < 4; ++ks) { const bf16x8_t kb = *(const bf16x8_t*)(Kl + (k0 + t * 16 + lr) * 272 + (ks * 32 + 8 * lq) * 2); sv[t] = MFMA16(qa[ks], kb, sv[t]); } }
                const int rb = hl * 465 + (rs + b - qt + 7) * 31 + 15;
#pragma unroll
                for (int t = 0; t < 2; ++t)
#pragma unroll
                    for (int rg = 0; rg < 4; ++rg) { const int jc = k0 + t * 16 + lr - (mt * 16 + lq * 4 + rg); const bool ok = (unsigned)(jc - lo4[rg]) < 16u;
                        sv[t][rg] = ok ? sv[t][rg] + rp[rb + jc] : -1e30f; }
                f32x4 mx;
#pragma unroll
                for (int rg = 0; rg < 4; ++rg) { float m = fmaxf(sv[0][rg], sv[1][rg]);
                    m = fmaxf(m, __uint_as_float(row_ror<8>(__float_as_uint(m)))); m = fmaxf(m, __uint_as_float(row_ror<4>(__float_as_uint(m)))); m = fmaxf(m, __uint_as_float(row_ror<2>(__float_as_uint(m)))); m = fmaxf(m, __uint_as_float(row_ror<1>(__float_as_uint(m)))); mx[rg] = fmaxf(m, mrow[rg]); }
                f32x4 corr;
#pragma unroll
                for (int rg = 0; rg < 4; ++rg) { corr[rg] = __builtin_amdgcn_exp2f(mrow[rg] - mx[rg]); mrow[rg] = mx[rg]; }
                lrow *= corr;
#pragma unroll
                for (int i = 0; i < 8; ++i) o[i] *= corr;
#pragma unroll
                for (int t = 0; t < 2; ++t) { float pv[4];
#pragma unroll
                    for (int rg = 0; rg < 4; ++rg) { pv[rg] = __builtin_amdgcn_exp2f(sv[t][rg] - mx[rg]); lrow[rg] += pv[rg]; }
                    const u32 p01 = pk2(pv[0], pv[1]), p23 = pk2(pv[2], pv[3]); bf16_t* pp = Pt + (lq * 4) * 64 + t * 16 + lr;
                    pp[0] = (bf16_t)(p01 & 0xffffu); pp[64] = (bf16_t)(p01 >> 16); pp[128] = (bf16_t)(p23 & 0xffffu); pp[192] = (bf16_t)(p23 >> 16); }
                const bf16x8_t pa0 = *(const bf16x8_t*)(Pt + lr * 64 + 8 * lq);
#pragma unroll
                for (int i = 0; i < 8; ++i) { const bf16x8_t vb = *(const bf16x8_t*)(Vl + (i * 16 + lr) * 144 + (k0 + 8 * lq) * 2); o[i] = MFMA16(pa0, vb, o[i]); }
            } else {
                f32x4 sv[4];
#pragma unroll
                for (int t = 0; t < 4; ++t) { sv[t] = (f32x4){0.f, 0.f, 0.f, 0.f};
#pragma unroll
                    for (int ks = 0; ks < 4; ++ks) { const bf16x8_t kb = *(const bf16x8_t*)(Kl + (t * 16 + lr) * 272 + (ks * 32 + 8 * lq) * 2); sv[t] = MFMA16(qa[ks], kb, sv[t]); } }
                if (loc && (b == 0 || b == 4)) {
                    const int d0 = q0 - key0 + lq * 4 - lr;
#pragma unroll
                    for (int t = 0; t < 4; ++t)
#pragma unroll
                        for (int rg = 0; rg < 4; ++rg) { const int dd = d0 + rg - 16 * t; sv[t][rg] = (abs(dd) <= 128) ? sv[t][rg] : -1e30f; }
                }
                ATT_TAIL(4, 0);
            }
#undef ATT_TAIL
            { int bn = b + 1; while (bn <= blast && !BVALID(bn)) ++bn;
              if (bn <= blast) { STAGEW(((cnt + 1) & 1) * BUF_B); __syncthreads(); int b2 = bn + 1; while (b2 <= blast && !BVALID(b2)) ++b2; if (b2 <= blast) PREFETCH(b2); } }
            ++cnt;
        }
#undef KEY0
#undef BVALID
#undef PREFETCH
#undef STAGEW
        f32x4 inv;
#pragma unroll
        for (int rg = 0; rg < 4; ++rg) { float l = row_allsum_f(lrow[rg]);
            if (kind == 1) l += __builtin_amdgcn_exp2f(p.cd_sink[h] * 1.4426950408889634f - mrow[rg]);
            inv[rg] = 1.f / l; }
        const int ycol = (kind == 0 ? 0 : 1024) + h * 128;
#pragma unroll
        for (int i = 0; i < 8; ++i)
#pragma unroll
            for (int rg = 0; rg < 4; ++rg) YM[(size_t)(q0 + lq * 4 + rg) * DM + ycol + i * 16 + lr] = (bf16_t)f2bf(o[i][rg] * inv[rg]);
    }
}

template <int MODE>
__device__ __forceinline__ void ph_gemm_ctx(const bf16_t* A, const bf16_t* Wt, const float* base, const float* gate, float* outf, bf16_t* outb, unsigned char* smem) {
    const int tid = TID(), lane = tid & 63, wave = tid >> 6, lr = lane & 15, lq = lane >> 4;
    constexpr int ROWB = 528, A_B = 32 * ROWB, BUF = 96 * ROWB;
    for (int bi = blockIdx.x; bi < 256; bi += gridDim.x) {
        const int r0 = (bi >> 5) * 32, c0 = (bi & 31) * 64;
        const int row0 = r0 + (wave & 1) * 16, col0 = c0 + (wave >> 1) * 16;
        u32x4 st[6];
#define GC_LOAD(kc) do { _Pragma("unroll") for (int i = 0; i < 6; ++i) { const int pc = tid + NTHR * i; const int rw = pc >> 5, c = pc & 31; \
            st[i] = rw < 32 ? *(const u32x4*)(A + (size_t)(r0 + rw) * DM + (kc) * 256 + c * 8) : *(const u32x4*)(Wt + (size_t)(c0 + rw - 32) * DM + (kc) * 256 + c * 8); } } while (0)
#define GC_STORE(bo) do { _Pragma("unroll") for (int i = 0; i < 6; ++i) { const int pc = tid + NTHR * i; *(u32x4*)(smem + (bo) + (pc >> 5) * ROWB + (pc & 31) * 16) = st[i]; } } while (0)
        GC_LOAD(0);
        __syncthreads();
        GC_STORE(0);
        __syncthreads();
        GC_LOAD(1);
        f32x4 acc = {0.f, 0.f, 0.f, 0.f}, acc2 = {0.f, 0.f, 0.f, 0.f};
#pragma unroll
        for (int kc = 0; kc < 8; ++kc) {
            const unsigned char* Al = smem + (kc & 1) * BUF + ((wave & 1) * 16 + lr) * ROWB; const unsigned char* Bl = smem + (kc & 1) * BUF + A_B + ((wave >> 1) * 16 + lr) * ROWB;
#pragma unroll
            for (int i = 0; i < 8; i += 2) {
                acc = MFMA16(*(const bf16x8_t*)(Al + (i * 32 + 8 * lq) * 2), *(const bf16x8_t*)(Bl + (i * 32 + 8 * lq) * 2), acc);
                acc2 = MFMA16(*(const bf16x8_t*)(Al + ((i + 1) * 32 + 8 * lq) * 2), *(const bf16x8_t*)(Bl + ((i + 1) * 32 + 8 * lq) * 2), acc2); }
            if (kc < 7) { GC_STORE(((kc + 1) & 1) * BUF); __syncthreads(); if (kc < 6) GC_LOAD(kc + 2); }
        }
#undef GC_LOAD
#undef GC_STORE
        acc += acc2;
#pragma unroll
        for (int rg = 0; rg < 4; ++rg) { const size_t off = (size_t)(row0 + lq * 4 + rg) * DM + col0 + lr;
            if (MODE == 0) outf[off] = base[off] + gate[col0 + lr] * acc[rg]; else outb[off] = (bf16_t)f2bf(acc[rg]); }
    }
}

#define XB_TMO      128
#define XB_XCNT(j)  (256  + 64 * (j))
#define XB_XSUB(j)  (1280 + 64 * (j))
#define XB_XGEN(j)  (2304 + 64 * (j))
#define XB_TOP      3328
#define XB_TOPGEN   3392
#define XCD_BAR_WORDS 3456
#define XB_SPIN_CAP (1u << 18)

__device__ __forceinline__ unsigned xb_ld(unsigned* p)              { return __hip_atomic_load(p, __ATOMIC_RELAXED, __HIP_MEMORY_SCOPE_AGENT); }
__device__ __forceinline__ unsigned xb_add(unsigned* p, unsigned v) { return __hip_atomic_fetch_add(p, v, __ATOMIC_RELAXED, __HIP_MEMORY_SCOPE_AGENT); }
__device__ __forceinline__ unsigned xb_xcc_id() { return (unsigned)__builtin_amdgcn_s_getreg((3 << 11) | 20) & 0xFu; }
#define XB_SPIN(cond, bar) do { unsigned _sp = 0; while (cond) { __builtin_amdgcn_s_sleep(1); \
    if ((++_sp & 255u) == 0u) { if (xb_ld(&(bar)[XB_TMO])) break; if (_sp > XB_SPIN_CAP) { atomicAdd(&(bar)[XB_TMO], 1u); break; } } } } while (0)

struct XcdBarrier {
    unsigned* bar; unsigned x;
    volatile __attribute__((address_space(3))) unsigned* st;
};

__device__ __forceinline__ XcdBarrier xcd_barrier_post(unsigned* bar, volatile __attribute__((address_space(3))) unsigned* st) {
    XcdBarrier b; b.bar = bar; b.x = xb_xcc_id(); b.st = st;
    if (TID() == 0) (void)xb_add(&bar[XB_XCNT(b.x)], 1u);
    return b;
}
__device__ __forceinline__ void xcd_barrier_complete(unsigned* bar, unsigned x, unsigned& nloc, unsigned& nx) {
    const unsigned G = gridDim.x * gridDim.y * gridDim.z;
    unsigned sum, cnt, mine, sp = 0u;
    for (;;) {
        sum = 0u; cnt = 0u; mine = 0u;
#pragma unroll
        for (unsigned j = 0; j < 16; ++j) { const unsigned c = xb_ld(&bar[XB_XCNT(j)]); sum += c; cnt += (c > 0u) ? 1u : 0u; mine = (j == x) ? c : mine; }
        if (sum == G) break;
        __builtin_amdgcn_s_sleep(1);
        if ((++sp & 255u) == 0u) { if (xb_ld(&bar[XB_TMO])) break; if (sp > XB_SPIN_CAP) { atomicAdd(&bar[XB_TMO], 1u); break; } }
    }
    nloc = mine > 0u ? mine : 1u; nx = cnt > 0u ? cnt : 1u;
}

__device__ __forceinline__ void xcd_barrier(const XcdBarrier& b) {
    asm volatile("s_waitcnt vmcnt(0)" ::: "memory");
    __syncthreads();
    if (TID() == 0) {
        unsigned* bar = b.bar;
        __builtin_amdgcn_s_waitcnt(0);
        unsigned nloc = b.st[0], nx = b.st[1];
        if (nloc == 0u) { xcd_barrier_complete(bar, b.x, nloc, nx); b.st[0] = nloc; b.st[1] = nx; }
        const unsigned old = xb_add(&bar[XB_XSUB(b.x)], 1u);
        const unsigned gen = old / nloc;
        if (old + 1u == (gen + 1u) * nloc) {
            __builtin_amdgcn_fence(__ATOMIC_RELEASE, "agent");
            asm volatile("s_waitcnt vmcnt(0)" ::: "memory");
            const unsigned og = xb_add(&bar[XB_TOP], 1u);
            const unsigned tg = og / nx;
            if (og + 1u == (tg + 1u) * nx) xb_add(&bar[XB_TOPGEN], 1u);
            else XB_SPIN(xb_ld(&bar[XB_TOPGEN]) == tg, bar);
            __builtin_amdgcn_fence(__ATOMIC_ACQUIRE, "agent");
            xb_add(&bar[XB_XGEN(b.x)], 1u);
            asm volatile("s_waitcnt vmcnt(0)" ::: "memory");
        } else {
            XB_SPIN(xb_ld(&bar[XB_XGEN(b.x)]) == gen, bar);
            __builtin_amdgcn_fence(__ATOMIC_ACQUIRE, "agent");
            asm volatile("s_waitcnt vmcnt(0)" ::: "memory");
        }
    }
    __syncthreads();
}


enum { P_MOD = 0, P_TABLES, P_NORM_L0A, P_GEMM_AB, P_PREP_AB, P_SA, P_SB, P_SC, P_GEMM_OUT0, P_NORM_L0B, P_GEMM_Q0, P_ROUTE0, P_EXPERTS0,
       P_GEMM_CD, P_PREP_CD, P_ATTN, P_GEMM_OUT1, P_NORM_L1B, P_GEMM_Q1, P_ROUTE1, P_EXPERTS1, P_COUNT };

#ifndef PROBE_REP
#define PROBE_REP 0u
#endif
#ifndef PROBE_ABL
#define PROBE_ABL 0
#endif
template <int PH, bool DUMMY = false>
__device__ __forceinline__ void run_phase(const Params& p, unsigned char* smem) {
    float* const out_ = DUMMY ? (float*)(p.ws + OFF_SCR) : p.out;
    const float* modv = (const float*)(p.ws + OFF_MODV);
    float* XC = (float*)(p.ws + OFF_XC);
    bf16_t* H = (bf16_t*)(p.ws + OFF_H); bf16_t* YM = (bf16_t*)(p.ws + OFF_YM); bf16_t* QP = (bf16_t*)(p.ws + OFF_QP); bf16_t* PAB = (bf16_t*)(p.ws + OFF_PAB);
    if constexpr (PH == P_MOD) { ph_mod(p, smem); ph_colmax(p); }
    if constexpr (PH == P_TABLES) { ph_transpose_weights(p, smem); ph_conv_tables(p); }
    if constexpr (PH == P_NORM_L0A) { ph_norm(p, 0, 0, p.x, p.ctx, NT, false, nullptr, nullptr, nullptr, true); if (!DUMMY) ph_transpose_weights_i8(p, smem); }
    if constexpr (PH == P_GEMM_AB) { pg8::Gemm g{(const bf16_t*)(p.ws + OFF_H8), (const bf16_t*)(p.ws + OFF_WT_AB), NT, 7424, 1024}; pg8::StaticOrder S; S.init(NT, 7424, (int)gridDim.x, (int)blockIdx.x); pg8::EpiI8 E{PAB, PAB_LD, (const float*)(p.ws + OFF_HS8), (const float*)(p.ws + OFF_WSC)}; pg8::gemm_phase<pg8::EpiI8, pg8::StaticOrder, true, true, true>((PG8_LAS unsigned char*)smem, g, S, E); }
    if constexpr (PH == P_PREP_AB) ph_prep_ab(p, smem);
    if constexpr (PH == P_SA) ph_sa(p, smem, DUMMY ? PROBE_ABL : 0);
    if constexpr (PH == P_SB) { ph_sb(p); if (!DUMMY) conv_table_rows(p, 2 * 16384, 4 * 16384); }
    if constexpr (PH == P_SC) ph_sc(p, smem);
    if constexpr (PH == P_GEMM_OUT0) { pg8::Gemm g{YM, (const bf16_t*)(p.ws + OFF_WT_ABOUT), NL, 2048, 2048}; pg8::StaticOrder S; S.init(NL, 2048, (int)gridDim.x, (int)blockIdx.x); pg8::EpiBf16<0> E{QP, DM, nullptr, 0, 0, 1.f}; pg8::gemm_phase<pg8::EpiBf16<0>, pg8::StaticOrder, true, true>((PG8_LAS unsigned char*)smem, g, S, E); ph_gemm_ctx<1>(YM + (size_t)NL * DM, (const bf16_t*)(p.ws + OFF_WT_ABOUT), nullptr, nullptr, nullptr, QP + (size_t)NL * DM, smem); }
    if constexpr (PH == P_NORM_L0B) ph_norm(p, 0, 1, p.x, p.ctx, NT, true, QP, out_, DUMMY ? out_ : XC);
    if constexpr (PH == P_GEMM_Q0) { pg8::Gemm g{H, (const bf16_t*)(p.ws + OFF_WT_PQ0), NL, 2048, 2048}; pg8::StaticOrder S; S.init(NL, 2048, (int)gridDim.x, (int)blockIdx.x); pg8::EpiBf16<0> E{QP, DM, nullptr, 0, 0, 1.f}; pg8::gemm_phase<pg8::EpiBf16<0>, pg8::StaticOrder, true, true>((PG8_LAS unsigned char*)smem, g, S, E);  ph_gemm_ctx<1>(H + (size_t)NL * DM, (const bf16_t*)(p.ws + OFF_WT_PQ0), nullptr, nullptr, nullptr, QP + (size_t)NL * DM, smem); }
    if constexpr (PH == P_ROUTE0) ph_route(p, 0, NT, smem);
    if constexpr (PH == P_EXPERTS0) ph_experts(p, 0, NT, p.out, XC, out_, DUMMY ? out_ : XC, smem, !DUMMY, DUMMY ? PROBE_ABL : 0);
    if constexpr (PH == P_GEMM_CD) { pg8::Gemm g{(const bf16_t*)(p.ws + OFF_H8), (const bf16_t*)(p.ws + OFF_WT_CD), NT, 4608, 1024}; pg8::StaticOrder S; S.init(NT, 4608, (int)gridDim.x, (int)blockIdx.x); pg8::EpiI8 E{PAB, PCD_LD, (const float*)(p.ws + OFF_HS8), (const float*)(p.ws + OFF_WSC) + 7424}; pg8::gemm_phase<pg8::EpiI8, pg8::StaticOrder, true, true, true>((PG8_LAS unsigned char*)smem, g, S, E); }
    if constexpr (PH == P_PREP_CD) ph_prep_cd(p, smem);
    if constexpr (PH == P_ATTN) ph_attn(p, smem);
    if constexpr (PH == P_GEMM_OUT1) { pg8::Gemm g{YM, (const bf16_t*)(p.ws + OFF_WT_CDOUT), NL, 2048, 2048}; pg8::StaticOrder S; S.init(NL, 2048, (int)gridDim.x, (int)blockIdx.x); pg8::EpiBf16<0> E{QP, DM, nullptr, 0, 0, 1.f}; pg8::gemm_phase<pg8::EpiBf16<0>, pg8::StaticOrder, true, true>((PG8_LAS unsigned char*)smem, g, S, E); }
    if constexpr (PH == P_NORM_L1B) ph_norm(p, 1, 1, p.out, XC, NL, true, QP, out_, XC);
    if constexpr (PH == P_GEMM_Q1) { pg8::Gemm g{H, (const bf16_t*)(p.ws + OFF_WT_PQ1), NL, 2048, 2048}; pg8::StaticOrder S; S.init(NL, 2048, (int)gridDim.x, (int)blockIdx.x); pg8::EpiBf16<0> E{QP, DM, nullptr, 0, 0, 1.f}; pg8::gemm_phase<pg8::EpiBf16<0>, pg8::StaticOrder, true, true>((PG8_LAS unsigned char*)smem, g, S, E); }
    if constexpr (PH == P_ROUTE1) ph_route(p, 1, NL, smem);
    if constexpr (PH == P_EXPERTS1) ph_experts(p, 1, NL, p.out, XC, out_, DUMMY ? out_ : XC, smem, false, DUMMY ? PROBE_ABL : 0);
}

constexpr int LDS_BYTES = 163840;
template <int PH> __device__ __forceinline__ void run_from(const Params& p, unsigned char* smem, cg::grid_group& grid, const XcdBarrier& bar) {
    run_phase<PH>(p, smem);
    if constexpr (((PROBE_REP >> PH) & 1u) != 0u && PH != P_SB && PH != P_MOD) { xcd_barrier(bar); run_phase<PH, true>(p, smem); }
    if constexpr (PH + 1 < P_COUNT) {
        if constexpr (PH == P_MOD) __syncthreads();
        else if constexpr (PH == P_TABLES) { __syncthreads(); grid.sync(); }
        else xcd_barrier(bar);
        run_from<PH + 1>(p, smem, grid, bar);
    }
}
__global__ void __launch_bounds__(NTHR, 2) k_all(Params p) {
    extern __shared__ __attribute__((aligned(16))) unsigned char smem[];
    cg::grid_group grid = cg::this_grid();
    volatile __attribute__((address_space(3))) unsigned* st = (volatile __attribute__((address_space(3))) unsigned*)((__attribute__((address_space(3))) unsigned char*)smem + LDS_BYTES - 64);
    if (TID() < 16) st[TID()] = 0u;
    __syncthreads();
    const XcdBarrier bar = xcd_barrier_post((unsigned*)(p.ws + OFF_CTL), st);
    run_from<0>(p, smem, grid, bar);
}

extern "C" void kernel_launch(void* const* d_in, const int* in_sizes, int n_in, void* d_out, int out_size, void* d_ws, size_t ws_size, hipStream_t stream) {
    static int grid_blocks = 0;
    if (!grid_blocks) {
        int dev = 0, cus = 0, per_cu = 0;
        (void)hipGetDevice(&dev);
        (void)hipDeviceGetAttribute(&cus, hipDeviceAttributeMultiprocessorCount, dev);
        (void)hipFuncSetAttribute((const void*)k_all, hipFuncAttributeMaxDynamicSharedMemorySize, LDS_BYTES);
        (void)hipOccupancyMaxActiveBlocksPerMultiprocessor(&per_cu, (const void*)k_all, NTHR, LDS_BYTES);
        if (per_cu < 1) per_cu = 1;
        if (per_cu > 1) per_cu = 1;
        grid_blocks = cus * per_cu;
    }
    Params p{};
    const float** pp = (const float**)&p;
    for (int i = 0; i < 24; ++i) pp[i] = (const float*)d_in[i];
    p.out = (float*)d_out; p.ws = (unsigned char*)d_ws;
    (void)hipMemsetAsync((char*)d_ws + OFF_CTL, 0, CTL_BYTES, stream);
    void* args[] = {&p};
    hipError_t e = hipLaunchCooperativeKernel((const void*)k_all, dim3(grid_blocks), dim3(NTHR), args, LDS_BYTES, stream);
    if (e != hipSuccess) fprintf(stderr, "cooperative launch failed: %s (grid %d)\n", hipGetErrorString(e), grid_blocks);
}
```

```cpp
#include <hip/hip_runtime.h>
#include <hip/hip_cooperative_groups.h>
namespace cg = cooperative_groups;
#include <cstdint>
#include <cstdio>

typedef unsigned short bf16_t;
typedef unsigned int u32;
typedef float f32x4 __attribute__((ext_vector_type(4)));
typedef unsigned u32x4 __attribute__((ext_vector_type(4)));
typedef unsigned u32x2 __attribute__((ext_vector_type(2)));

constexpr int NL = 8192, NC = 256, NT = 8448, DM = 2048;
constexpr int PAB_LD = 7424, PCD_LD = 4608;
constexpr int NTHR = 512;
constexpr int CA_Q = 0, CA_K = 1024, CA_V = 2048, CA_O = 3072, CA_G = 4096, CB_Q = 4128, CB_K = 4640, CB_V = 5152, CB_R = 6176, CB_LR = 7200;

constexpr size_t MiB = 1u << 20;
constexpr size_t OFF_CTL = 0, CTL_BYTES = 1 * MiB;
constexpr size_t OFF_MODV = 64 * 1024;
constexpr size_t OFF_H = 2 * MiB;
constexpr size_t OFF_YM = 36 * MiB;
constexpr size_t OFF_QP = 70 * MiB;
constexpr size_t OFF_XC = 104 * MiB;
constexpr size_t OFF_EIDX = 106 * MiB;
constexpr size_t OFF_EG = 111 * MiB;
constexpr size_t OFF_PAB = 116 * MiB;
constexpr size_t OFF_AQ = 236 * MiB;
constexpr size_t OFF_AK = 253 * MiB;
constexpr size_t OFF_AKT = 270 * MiB;
constexpr size_t OFF_AVT = 287 * MiB;
constexpr size_t OFF_IG = 306 * MiB;
constexpr size_t OFF_LF = 307 * MiB;
constexpr size_t OFF_BQS = 308 * MiB;
constexpr size_t OFF_BKS = 325 * MiB;
constexpr size_t OFF_BKENDT = 342 * MiB;
constexpr size_t OFF_BVT = 359 * MiB;
constexpr size_t OFF_GDEC = 376 * MiB;
constexpr size_t OFF_DEC = 376 * MiB + 768 * 1024;
constexpr size_t OFF_HQ = 380 * MiB;
constexpr size_t OFF_HQS = 397 * MiB;
constexpr size_t OFF_KEYSB = 378 * MiB;
constexpr size_t OFF_TS = 377 * MiB;
constexpr size_t OFF_DCT = 410 * MiB;
constexpr size_t OFF_DST = 485 * MiB;
constexpr size_t OFF_TU0 = 592 * MiB, OFF_TV0 = 656 * MiB, OFF_TU1 = 720 * MiB, OFF_TV1 = 784 * MiB;
constexpr size_t OFF_WT_AB = 848 * MiB, OFF_WT_ABOUT = 877 * MiB, OFF_WT_CD = 885 * MiB, OFF_WT_CDOUT = 903 * MiB, OFF_WT_PQ0 = 911 * MiB, OFF_WT_PQ1 = 919 * MiB;
constexpr size_t OFF_SCR = 928 * MiB;
constexpr size_t OFF_H8 = 692 * MiB;
constexpr size_t OFF_HS8 = 397 * MiB + 64 * 1024;
constexpr size_t OFF_WSC = 397 * MiB + 128 * 1024;
constexpr size_t OFF_CMAX = 256 * 1024;
constexpr size_t OFF_CQ = 236 * MiB;
constexpr size_t OFF_CK = 253 * MiB;
constexpr size_t OFF_DQ = 287 * MiB;
constexpr size_t OFF_DK = 308 * MiB;
constexpr size_t OFF_CVT = 270 * MiB;
constexpr size_t OFF_DVT = 313 * MiB;

struct Params {
    const float *x, *c, *ctx, *c_ctx, *mod_w, *mod_b, *norm_g, *ab_w_in, *ab_conv_w, *ab_conv_b, *ab_gate_b, *ab_alpha_w2,
        *ab_alpha_b, *ab_head_g, *ab_w_out, *cd_w_in, *cd_qk_g, *cd_rpb, *cd_sink, *cd_w_out, *peer_w_q, *peer_sub_keys, *peer_u, *peer_v;
    float* out; unsigned char* ws;
};

__device__ __forceinline__ int TID() { int t = (int)__builtin_amdgcn_workitem_id_x(); asm volatile("" : "+v"(t)); return t; }
__device__ __forceinline__ float bf2f(bf16_t v) { return __uint_as_float(((u32)v) << 16); }
typedef float f32x2v_t __attribute__((ext_vector_type(2)));
typedef __bf16 bf16x2v_t __attribute__((ext_vector_type(2)));
__device__ __forceinline__ u32 pk2(float lo, float hi) { const f32x2v_t v = {lo, hi}; const bf16x2v_t b = __builtin_convertvector(v, bf16x2v_t); return __builtin_bit_cast(unsigned, b); }
__device__ __forceinline__ u32 f2bf(float f) { return pk2(f, 0.f) & 0xffffu; }
__device__ __forceinline__ float bfl(u32 w) { return __uint_as_float(w << 16); }
__device__ __forceinline__ float bfh(u32 w) { return __uint_as_float(w & 0xffff0000u); }
__device__ __forceinline__ float wave_sum(float v) {
#pragma unroll
    for (int o = 1; o < 64; o <<= 1) v += __shfl_xor(v, o);
    return v;
}
__device__ __forceinline__ float wave_max(float v) {
#pragma unroll
    for (int o = 1; o < 64; o <<= 1) v = fmaxf(v, __shfl_xor(v, o));
    return v;
}
__device__ __forceinline__ u32 wave_max_u32(u32 v) {
#pragma unroll
    for (int o = 1; o < 64; o <<= 1) { u32 t = (u32)__shfl_xor((int)v, o); v = t > v ? t : v; }
    return v;
}
__device__ __forceinline__ float frcp(float a) { return __builtin_amdgcn_rcpf(a); }
__device__ __forceinline__ float siluf(float a) { return a * frcp(1.f + __expf(-a)); }
__device__ __forceinline__ float sigmoidf_(float a) { return frcp(1.f + __expf(-a)); }
__device__ __forceinline__ float logsigf(float a) { return a < 0.f ? a - log1pf(__expf(a)) : -log1pf(__expf(-a)); }
__device__ __forceinline__ float gelu_tanh(float v) { return 0.5f * v * (1.f + tanhf(0.7978845608028654f * (v + 0.044715f * v * v * v))); }

namespace pg8 {
#define PG8_LAS __attribute__((address_space(3)))
typedef unsigned short bf16_t;
typedef short bf16x8 __attribute__((ext_vector_type(8)));
typedef float f32x4 __attribute__((ext_vector_type(4)));
typedef unsigned u32x4 __attribute__((ext_vector_type(4)));
typedef int i32x4_t __attribute__((ext_vector_type(4)));
constexpr int BM = 256, BK = 64, HALF = 128, HTB = HALF * BK * 2  , STAGE_BYTES = 8 * HTB, NXCD = 8, WGM = 8;

__host__ __device__ __forceinline__ int lds_byte(int r, int c) { const int st = (r >> 4) * 2 + (c >> 5), rr = r & 15, cc = c & 31, ob = rr * 64 + cc * 2; return st * 1024 + (ob ^ (((ob >> 9) & 1) << 5)); }
__host__ __device__ __forceinline__ void stage_rc(int b, int& R, int& C) { const int st = b / 1024, sb = b % 1024, swz = sb ^ (((sb >> 9) & 1) << 5); R = (st >> 1) * 16 + swz / 64; C = (st & 1) * 32 + (swz % 64) / 2; }
__host__ __device__ __forceinline__ int perm32(int rho) { const int n = rho >> 4, i = rho & 15; return 8 * (i >> 2) + 4 * n + (i & 3); }

struct Unit { int pm, pn; };
struct Gemm { const bf16_t* A; const bf16_t* Bt; int M, N, K; };

struct StaticOrder {
    int nM, nN, nwg, G, c;
    __host__ __device__ void init(int M, int N, int G_, int c_) { nM = M / BM; nN = N / BM; nwg = nM * nN; G = G_; c = c_; }
    __host__ __device__ bool next(int i, Unit& u) const {
        const long L = (long)i * G + c; if (L >= nwg) return false;
        int wgid = (int)L; { const int q = nwg / NXCD, r = nwg % NXCD, xcd = wgid % NXCD, off = wgid / NXCD; wgid = (xcd < r ? xcd * (q + 1) : r * (q + 1) + (xcd - r) * q) + off; }
        const int nig = WGM * nN, gid = wgid / nig, fm = gid * WGM, gsz = (nM - fm) < WGM ? (nM - fm) : WGM;
        u.pm = fm + ((wgid % nig) % gsz); u.pn = (wgid % nig) / gsz; return true;
    }
    __device__ __forceinline__ void a_ready(const Unit&) const {}
    __device__ __forceinline__ void done(const Unit&) const {}
};

__device__ __forceinline__ unsigned cvt_pk_bf16(float lo, float hi) { unsigned r; asm volatile("v_cvt_pk_bf16_f32 %0, %1, %2" : "=v"(r) : "v"(lo), "v"(hi)); return r; }
typedef float f32x2 __attribute__((ext_vector_type(2)));
__device__ __forceinline__ f32x2 gelu_pk(f32x2 v) {
    const f32x2 av = __builtin_elementwise_abs(v), d = av * 0.2316418882f + 1.0f;
    f32x2 t; t.x = __builtin_amdgcn_rcpf(d.x); t.y = __builtin_amdgcn_rcpf(d.y);
    f32x2 q = t * 0.5307027145f + (-0.7265760135f); q = q * t + 0.7107068705f; q = q * t + (-0.142248368f); q = q * t + 0.127414796f; q = q * t;
    const f32x2 s = (v * v) * (-0.72134752044f);
    f32x2 e; e.x = __builtin_amdgcn_exp2f(s.x); e.y = __builtin_amdgcn_exp2f(s.y);
    const f32x2 m = v * (q * e), r = v - m;
    f32x2 o; o.x = v.x < 0.f ? m.x : r.x; o.y = v.y < 0.f ? m.y : r.y; return o;
}

template <int ACT  > struct EpiBf16 {
    static constexpr bool PERM = true, AFTER_DRAIN = false; static_assert(ACT == 0 || ACT == 1, "EpiBf16: ACT is 0 (none) or 1 (gelu_pk)");
    bf16_t* O; int ldc; const float* bias; int split_cols; size_t split_stride; float scale0;
    __device__ __forceinline__ void operator()(const f32x4 (&acc)[2][2][4][2], const Unit& u, int wr, int wc, int fr, int fq) const {
        const int row0 = u.pm * BM + wr * 64 + fr; int colt = u.pn * BM; bf16_t* base = O;
        float sc = 1.f; if (split_cols) { const int t = colt / split_cols; base += (size_t)t * split_stride; colt -= t * split_cols; if (t == 0) sc = scale0; }
        const int col0 = colt + wc * 32 + 8 * fq, bcol0 = u.pn * BM + wc * 32 + 8 * fq;
        f32x4 bv[2][2];
#pragma unroll
        for (int bj = 0; bj < 2; ++bj)
#pragma unroll
            for (int n = 0; n < 2; ++n) bv[bj][n] = bias ? *(const f32x4*)(bias + bcol0 + bj * HALF + 4 * n) : (f32x4){0.f, 0.f, 0.f, 0.f};
#pragma unroll
        for (int ai = 0; ai < 2; ++ai)
#pragma unroll
            for (int m = 0; m < 4; ++m) { bf16_t* rowp = base + (size_t)(row0 + ai * HALF + m * 16) * ldc + col0;
#pragma unroll
                for (int bj = 0; bj < 2; ++bj) { f32x4 v0 = acc[ai][bj][m][0] + bv[bj][0], v1 = acc[ai][bj][m][1] + bv[bj][1];
                    if (ACT == 1) { f32x2 a = gelu_pk((f32x2){v0[0], v0[1]}), b = gelu_pk((f32x2){v0[2], v0[3]}), c = gelu_pk((f32x2){v1[0], v1[1]}), d = gelu_pk((f32x2){v1[2], v1[3]});
                        v0 = (f32x4){a.x, a.y, b.x, b.y}; v1 = (f32x4){c.x, c.y, d.x, d.y}; }
                    v0 = v0 * sc; v1 = v1 * sc; u32x4 w; w.x = cvt_pk_bf16(v0[0], v0[1]); w.y = cvt_pk_bf16(v0[2], v0[3]); w.z = cvt_pk_bf16(v1[0], v1[1]); w.w = cvt_pk_bf16(v1[2], v1[3]);
                    *(u32x4*)(rowp + bj * HALF) = w; } }
    }
};

struct EpiI8 {
    static constexpr bool PERM = true, AFTER_DRAIN = false;
    bf16_t* O; int ldc; const float* srow; const float* scol;
    __device__ __forceinline__ void operator()(const f32x4 (&acc)[2][2][4][2], const Unit& u, int wr, int wc, int fr, int fq) const {
        const int row0 = u.pm * BM + wr * 64 + fr; const int col0 = u.pn * BM + wc * 32 + 8 * fq;
        f32x4 cs[2][2];
#pragma unroll
        for (int bj = 0; bj < 2; ++bj)
#pragma unroll
            for (int n = 0; n < 2; ++n) cs[bj][n] = *(const f32x4*)(scol + col0 + bj * HALF + 4 * n);
#pragma unroll
        for (int ai = 0; ai < 2; ++ai)
#pragma unroll
            for (int m = 0; m < 4; ++m) { const int row = row0 + ai * HALF + m * 16; const float sr = srow[row]; bf16_t* rowp = O + (size_t)row * ldc + col0;
#pragma unroll
                for (int bj = 0; bj < 2; ++bj) {
                    const i32x4_t a0 = __builtin_bit_cast(i32x4_t, acc[ai][bj][m][0]), a1 = __builtin_bit_cast(i32x4_t, acc[ai][bj][m][1]);
                    const f32x4 v0 = (f32x4){(float)a0[0], (float)a0[1], (float)a0[2], (float)a0[3]} * cs[bj][0] * sr, v1 = (f32x4){(float)a1[0], (float)a1[1], (float)a1[2], (float)a1[3]} * cs[bj][1] * sr;
                    u32x4 w; w.x = cvt_pk_bf16(v0[0], v0[1]); w.y = cvt_pk_bf16(v0[2], v0[3]); w.z = cvt_pk_bf16(v1[0], v1[1]); w.w = cvt_pk_bf16(v1[2], v1[3]);
                    *(u32x4*)(rowp + bj * HALF) = w; } }
    }
};
struct EpiResid {
    static constexpr bool PERM = false, AFTER_DRAIN = false;
    const float* xin_lat; const float* xin_ctx; float* xout_lat; float* xout_ctx; const float* gate_lat; const float* gate_ctx;
    __device__ __forceinline__ void operator()(const f32x4 (&acc)[2][2][4][2], const Unit& u, int wr, int wc, int fr, int fq) const {
        const bool isc = u.pm * BM >= 8192;
        const float* xin = isc ? xin_ctx - (size_t)8192 * 2048 : xin_lat; float* xout = isc ? xout_ctx - (size_t)8192 * 2048 : xout_lat; const float* gate = isc ? gate_ctx : gate_lat;
        const int row0 = u.pm * BM + wr * 64 + fr, col0 = u.pn * BM + wc * 32 + 4 * fq;
#pragma unroll
        for (int bj = 0; bj < 2; ++bj)
#pragma unroll
            for (int n = 0; n < 2; ++n) { const f32x4 g = *(const f32x4*)(gate + col0 + bj * HALF + n * 16);
#pragma unroll
                for (int ai = 0; ai < 2; ++ai) {
#pragma unroll
                    for (int m = 0; m < 4; ++m) { const size_t off = (size_t)(row0 + ai * HALF + m * 16) * 2048 + col0 + bj * HALF + n * 16;
                        const f32x4 b = *(const f32x4*)(xin + off); *(f32x4*)(xout + off) = b + g * acc[ai][bj][m][n]; }
                    asm volatile("" ::: "memory"); } }
    }
};
template <class Epi, class Sched, bool ALIGN_EPI = false, bool SP2 = false, bool I8 = false>
__device__ __forceinline__ void gemm_phase(PG8_LAS unsigned char* lds, const Gemm g, const Sched& S, const Epi& E) {
    const int tid = TID(), wid = __builtin_amdgcn_readfirstlane(tid >> 6), lane = tid & 63, wr = wid >> 2, wc = wid & 3, fr = lane & 15, fq = lane >> 4;
    const int K = g.K, nt = K / BK;
    unsigned voffA[2], voffB[2];
#pragma unroll
    for (int i = 0; i < 2; ++i) { int R, C; stage_rc(tid * 16 + i * 8192, R, C); const int Rb = Epi::PERM ? ((R & ~31) + perm32(R & 31)) : R;
        voffA[i] = (unsigned)(R * K + C) * 2u; voffB[i] = (unsigned)(Rb * K + C) * 2u; }
    const size_t kstep = (size_t)(BK * 2);
    const size_t hstep = (size_t)HALF * K * 2;
    const size_t tstep = 2 * hstep;
    const unsigned ldsw = (unsigned)wid * 1024u;
    const int aoff = lds_byte(wr * 64 + fr, fq * 8), boff = lds_byte(wc * 32 + fr, fq * 8);
#define PG8_SA(b, h) (((b) * 2 + (h)) * HTB)
#define PG8_SB(b, h) ((4 + (b) * 2 + (h)) * HTB)
#define PG8_STAGE(bufoff, gbase, voff) do { _Pragma("unroll") for (int _i = 0; _i < 2; ++_i) \
        __builtin_amdgcn_global_load_lds((const unsigned*)((const char*)(gbase) + (voff)[_i]), (PG8_LAS unsigned*)(lds + (bufoff) + ldsw + _i * 8192), 16, 0, 0); } while (0)
#define PG8_LDA(dst, b, h) do { _Pragma("unroll") for (int m = 0; m < 4; ++m) _Pragma("unroll") for (int k = 0; k < 2; ++k) dst[m][k] = *(const PG8_LAS bf16x8*)(lds + PG8_SA(b, h) + aoff + m * 2048 + k * 1024); } while (0)
#define PG8_LDB(dst, b, h) do { _Pragma("unroll") for (int n = 0; n < 2; ++n) _Pragma("unroll") for (int k = 0; k < 2; ++k) dst[n][k] = *(const PG8_LAS bf16x8*)(lds + PG8_SB(b, h) + boff + n * 2048 + k * 1024); } while (0)
#define PG8_MMA(ai, bj, At, Bt) do { __builtin_amdgcn_s_setprio(1); _Pragma("unroll") for (int m = 0; m < 4; ++m) _Pragma("unroll") for (int n = 0; n < 2; ++n) _Pragma("unroll") for (int k = 0; k < 2; ++k) \
        acc[ai][bj][m][n] = I8 ? __builtin_bit_cast(f32x4, __builtin_amdgcn_mfma_i32_16x16x64_i8(__builtin_bit_cast(i32x4_t, Bt[n][k]), __builtin_bit_cast(i32x4_t, At[m][k]), __builtin_bit_cast(i32x4_t, acc[ai][bj][m][n]), 0, 0, 0)) \
                                 : __builtin_amdgcn_mfma_f32_16x16x32_bf16(Bt[n][k], At[m][k], acc[ai][bj][m][n], 0, 0, 0); __builtin_amdgcn_s_setprio(0); } while (0)
#define PG8_WAIT_V(n) asm volatile("s_waitcnt vmcnt(" #n ")" ::: "memory")
#define PG8_WAIT_L(n) asm volatile("s_waitcnt lgkmcnt(" #n ")" ::: "memory")
#define PG8_BAR __builtin_amdgcn_s_barrier()
#define PG8_SCHED __builtin_amdgcn_sched_barrier(0)
    Unit cur, nxt; int ui = 0;
    if (!S.next(0, cur)) return;
    f32x4 acc[2][2][4][2];
#pragma unroll
    for (int a = 0; a < 2; ++a)
#pragma unroll
        for (int b = 0; b < 2; ++b)
#pragma unroll
            for (int m = 0; m < 4; ++m)
#pragma unroll
                for (int n = 0; n < 2; ++n) acc[a][b][m][n] = (f32x4){0.f, 0.f, 0.f, 0.f};
    bf16x8 At[4][2], B0[2][2], B1[2][2];
    const char* cA = (const char*)g.A + (size_t)cur.pm * tstep; const char* cB = (const char*)g.Bt + (size_t)cur.pn * tstep;
    S.a_ready(cur);
    if constexpr (SP2) {
        PG8_STAGE(PG8_SB(0, 0), cB, voffB); PG8_STAGE(PG8_SB(0, 1), cB + hstep, voffB); PG8_STAGE(PG8_SA(0, 0), cA, voffA); PG8_STAGE(PG8_SA(0, 1), cA + hstep, voffA);
        if (wr == 1) PG8_BAR;
        PG8_WAIT_V(2); PG8_BAR;
        PG8_STAGE(PG8_SB(1, 0), cB + kstep, voffB); PG8_STAGE(PG8_SA(1, 0), cA + kstep, voffA); PG8_STAGE(PG8_SB(1, 1), cB + hstep + kstep, voffB);
        PG8_WAIT_V(6); PG8_BAR;
    } else {
        PG8_STAGE(PG8_SB(0, 0), cB, voffB); PG8_STAGE(PG8_SA(0, 0), cA, voffA); PG8_STAGE(PG8_SB(0, 1), cB + hstep, voffB); PG8_STAGE(PG8_SA(0, 1), cA + hstep, voffA);
        if (wr == 1) PG8_BAR;
        PG8_WAIT_V(4); PG8_BAR;
        PG8_STAGE(PG8_SB(1, 0), cB + kstep, voffB); PG8_STAGE(PG8_SA(1, 0), cA + kstep, voffA); PG8_STAGE(PG8_SB(1, 1), cB + hstep + kstep, voffB);
        PG8_WAIT_V(6); PG8_BAR;
    }
    for (;;) {
        const bool has_next = S.next(ui + 1, nxt);
        const char* nA = has_next ? (const char*)g.A + (size_t)nxt.pm * tstep : cA; const char* nB = has_next ? (const char*)g.Bt + (size_t)nxt.pn * tstep : cB;
        for (int t = 0; t < nt; t += 2) {
            const bool last = (t == nt - 2);
            const char* a1 = cA + (size_t)(t + 1) * kstep;
            const char* a2 = last ? nA : cA + (size_t)(t + 2) * kstep; const char* b2 = last ? nB : cB + (size_t)(t + 2) * kstep;
            const char* a3 = a2 + kstep; const char* b3 = b2 + kstep;
            if (last && has_next) S.a_ready(nxt);
            if constexpr (SP2) {
            PG8_LDB(B0, 0, 0); PG8_LDB(B1, 0, 1); PG8_SCHED; PG8_LDA(At, 0, 0); PG8_STAGE(PG8_SA(1, 1), a1 + hstep, voffA);
            PG8_WAIT_V(8); PG8_WAIT_L(0); PG8_BAR; PG8_MMA(0, 0, At, B0); PG8_MMA(0, 1, At, B1); PG8_BAR; PG8_SCHED;
            PG8_LDA(At, 0, 1); PG8_STAGE(PG8_SB(0, 0), b2, voffB); PG8_STAGE(PG8_SB(0, 1), b2 + hstep, voffB); PG8_STAGE(PG8_SA(0, 0), a2, voffA);
            PG8_WAIT_V(8); PG8_WAIT_L(0); PG8_BAR; PG8_MMA(1, 0, At, B0); PG8_MMA(1, 1, At, B1); PG8_BAR; PG8_SCHED;
            PG8_LDB(B0, 1, 0); PG8_LDB(B1, 1, 1); PG8_SCHED; PG8_LDA(At, 1, 0); PG8_STAGE(PG8_SA(0, 1), a2 + hstep, voffA);
            PG8_WAIT_V(8); PG8_WAIT_L(0); PG8_BAR; PG8_MMA(0, 0, At, B0); PG8_MMA(0, 1, At, B1); PG8_BAR; PG8_SCHED;
            PG8_LDA(At, 1, 1); PG8_STAGE(PG8_SB(1, 0), b3, voffB); PG8_STAGE(PG8_SB(1, 1), b3 + hstep, voffB); PG8_STAGE(PG8_SA(1, 0), a3, voffA);
            PG8_WAIT_V(8); PG8_WAIT_L(0); PG8_BAR; PG8_MMA(1, 0, At, B0); PG8_MMA(1, 1, At, B1); PG8_BAR; PG8_SCHED;
            } else {
            PG8_LDB(B0, 0, 0); PG8_SCHED; PG8_LDA(At, 0, 0); PG8_STAGE(PG8_SA(1, 1), a1 + hstep, voffA);
            PG8_WAIT_L(8); PG8_BAR; PG8_WAIT_L(0); PG8_MMA(0, 0, At, B0); PG8_BAR; PG8_SCHED;
            PG8_LDB(B1, 0, 1); PG8_STAGE(PG8_SB(0, 0), b2, voffB);
            PG8_BAR; PG8_WAIT_L(0); PG8_MMA(0, 1, At, B1); PG8_BAR;
            PG8_LDA(At, 0, 1); PG8_STAGE(PG8_SA(0, 0), a2, voffA);
            PG8_BAR; PG8_WAIT_L(0); PG8_MMA(1, 0, At, B0); PG8_BAR; PG8_SCHED;
            PG8_STAGE(PG8_SB(0, 1), b2 + hstep, voffB);
            PG8_WAIT_V(6); PG8_BAR; PG8_MMA(1, 1, At, B1); PG8_BAR;
            PG8_LDB(B0, 1, 0); PG8_SCHED; PG8_LDA(At, 1, 0); PG8_STAGE(PG8_SA(0, 1), a2 + hstep, voffA);
            PG8_WAIT_L(8); PG8_BAR; PG8_WAIT_L(0); PG8_MMA(0, 0, At, B0); PG8_BAR; PG8_SCHED;
            PG8_LDB(B1, 1, 1); PG8_STAGE(PG8_SB(1, 0), b3, voffB);
            PG8_BAR; PG8_WAIT_L(0); PG8_MMA(0, 1, At, B1); PG8_BAR;
            PG8_LDA(At, 1, 1); PG8_STAGE(PG8_SA(1, 0), a3, voffA);
            PG8_BAR; PG8_WAIT_L(0); PG8_MMA(1, 0, At, B0); PG8_BAR; PG8_SCHED;
            PG8_STAGE(PG8_SB(1, 1), b3 + hstep, voffB);
            PG8_WAIT_V(6); PG8_BAR; PG8_MMA(1, 1, At, B1); PG8_BAR;
            }
        }
        if constexpr (ALIGN_EPI) { if (wr == 0) PG8_BAR; }
        if constexpr (!Epi::AFTER_DRAIN) { E(acc, cur, wr, wc, fr, fq); S.done(cur); }
        if (!has_next) break;
#pragma unroll
        for (int a = 0; a < 2; ++a)
#pragma unroll
            for (int b = 0; b < 2; ++b)
#pragma unroll
                for (int m = 0; m < 4; ++m)
#pragma unroll
                    for (int n = 0; n < 2; ++n) acc[a][b][m][n] = (f32x4){0.f, 0.f, 0.f, 0.f};
        cur = nxt; cA = nA; cB = nB; ++ui;
        if constexpr (ALIGN_EPI) { if (wr == 1) PG8_BAR; }
    }
    PG8_WAIT_V(0);
    if constexpr (!ALIGN_EPI) { if (wr == 0) PG8_BAR; }
    PG8_BAR;
    if constexpr (Epi::AFTER_DRAIN) { E.fused(acc, cur, wr, wc, fr, fq, lds, wid, lane); S.done(cur); }
#undef PG8_SA
#undef PG8_SB
#undef PG8_STAGE
#undef PG8_LDA
#undef PG8_LDB
#undef PG8_MMA
#undef PG8_WAIT_V
#undef PG8_WAIT_L
#undef PG8_BAR
#undef PG8_SCHED
}
}

#define LAS __attribute__((address_space(3)))
__device__ __forceinline__ void p0_transpose_item(const float* W, int K, int N, bf16_t* WT, LAS float* scr, int item, int lane) {
    const int nblk = N / 32, kb = item / nblk, nb = item % nblk, k0 = 64 * kb, n0 = 32 * nb;
#pragma unroll 8
    for (int i = 0; i < 32; ++i) { const int kk = 2 * i + (lane >> 5); scr[kk * 33 + (lane & 31)] = __builtin_nontemporal_load(&W[(size_t)(k0 + kk) * N + n0 + (lane & 31)]); }
    asm volatile("s_waitcnt lgkmcnt(0)" ::: "memory");
    const int c = lane & 7;
#pragma unroll
    for (int j = 0; j < 4; ++j) { const int n = (lane >> 3) + 8 * j; const LAS float* sp = scr + (8 * c) * 33 + n;
        u32x4 o; o.x = pk2(sp[0 * 33], sp[1 * 33]); o.y = pk2(sp[2 * 33], sp[3 * 33]); o.z = pk2(sp[4 * 33], sp[5 * 33]); o.w = pk2(sp[6 * 33], sp[7 * 33]);
        *(u32x4*)(WT + (size_t)(n0 + n) * K + k0 + 8 * c) = o; }
    asm volatile("s_waitcnt lgkmcnt(0)" ::: "memory");
}
__device__ __forceinline__ void ph_colmax(const Params& p) {
    unsigned* CM = (unsigned*)(p.ws + OFF_CTL + OFF_CMAX);
    constexpr int C_AB = 7232 / 4, C_CD = 4608 / 4, NIT = (C_AB + C_CD) * 16;
    for (int it = blockIdx.x * NTHR + TID(); it < NIT; it += gridDim.x * NTHR) {
        const int kc = it / (C_AB + C_CD), c = it % (C_AB + C_CD);
        const bool ab = c < C_AB; const int N = ab ? 7232 : 4608; const int c4 = ab ? c : c - C_AB;
        const f32x4* W = (const f32x4*)(ab ? p.ab_w_in : p.cd_w_in) + (size_t)(kc * 128) * (N / 4) + c4;
        f32x4 m = {0.f, 0.f, 0.f, 0.f};
#pragma unroll 8
        for (int k = 0; k < 128; ++k) { const f32x4 w = W[(size_t)k * (N / 4)]; m.x = fmaxf(m.x, fabsf(w.x)); m.y = fmaxf(m.y, fabsf(w.y)); m.z = fmaxf(m.z, fabsf(w.z)); m.w = fmaxf(m.w, fabsf(w.w)); }
        unsigned* o = CM + (ab ? 0 : 7424) + c4 * 4;
        atomicMax(o + 0, __float_as_uint(m.x)); atomicMax(o + 1, __float_as_uint(m.y)); atomicMax(o + 2, __float_as_uint(m.z)); atomicMax(o + 3, __float_as_uint(m.w));
    }
}
__device__ __forceinline__ void p0_transpose_item_i8(const float* W, int K, int N, unsigned char* WT, const unsigned* cmax, LAS float* scr, int item, int lane) {
    const int nblk = N / 32, kb = item / nblk, nb = item % nblk, k0 = 64 * kb, n0 = 32 * nb;
#pragma unroll 8
    for (int i = 0; i < 32; ++i) { const int kk = 2 * i + (lane >> 5); scr[kk * 33 + (lane & 31)] = __builtin_nontemporal_load(&W[(size_t)(k0 + kk) * N + n0 + (lane & 31)]); }
    asm volatile("s_waitcnt lgkmcnt(0)" ::: "memory");
    const int c = lane & 7;
#pragma unroll
    for (int j = 0; j < 4; ++j) { const int n = (lane >> 3) + 8 * j; const LAS float* sp = scr + (8 * c) * 33 + n;
        const float cm = __uint_as_float(cmax[n0 + n]); const float inv = cm > 0.f ? 127.f / cm : 0.f;
        u32 b[8];
#pragma unroll
        for (int e = 0; e < 8; ++e) b[e] = (u32)((int)rintf(sp[e * 33] * inv)) & 0xffu;
        u32x2 o; o.x = b[0] | (b[1] << 8) | (b[2] << 16) | (b[3] << 24); o.y = b[4] | (b[5] << 8) | (b[6] << 16) | (b[7] << 24);
        *(u32x2*)(WT + (size_t)(n0 + n) * K + k0 + 8 * c) = o; }
    asm volatile("s_waitcnt lgkmcnt(0)" ::: "memory");
}
__device__ __forceinline__ void ph_transpose_weights_i8(const Params& p, unsigned char* smem) {
    const int lane = TID() & 63, wave = TID() >> 6;
    LAS float* scr = (LAS float*)((LAS unsigned char*)smem + 32768 + wave * 12288);
    const int gw = blockIdx.x * 8 + wave, NGW = gridDim.x * 8;
    const unsigned* CM = (const unsigned*)(p.ws + OFF_CTL + OFF_CMAX); float* WSC = (float*)(p.ws + OFF_WSC);
    for (int i = blockIdx.x * NTHR + TID(); i < 7424 + 4608; i += gridDim.x * NTHR) WSC[i] = __uint_as_float(CM[i]) * (1.f / 127.f);
    constexpr int I_AB = 32 * (7232 / 32), I_CD = 32 * (4608 / 32);
    for (int it = gw; it < I_AB + I_CD; it += NGW) {
        if (it < I_AB) p0_transpose_item_i8(p.ab_w_in, 2048, 7232, p.ws + OFF_WT_AB, CM, scr, it, lane);
        else p0_transpose_item_i8(p.cd_w_in, 2048, 4608, p.ws + OFF_WT_CD, CM + 7424, scr, it - I_AB, lane);
    }
}
__device__ __forceinline__ void ph_transpose_weights(const Params& p, unsigned char* smem) {
    const int lane = TID() & 63, wave = TID() >> 6;
    LAS float* scr = (LAS float*)((LAS unsigned char*)smem + 32768 + wave * 12288);
    const int gw = blockIdx.x * 8 + wave, NGW = gridDim.x * 8;
    constexpr int I_SQ = 32 * 64;
    constexpr int NITEMS = 4 * I_SQ;
    for (int it = gw; it < NITEMS; it += NGW) {
        int r = it;
        if (r < I_SQ) { p0_transpose_item(p.ab_w_out, 2048, 2048, (bf16_t*)(p.ws + OFF_WT_ABOUT), scr, r, lane); continue; } r -= I_SQ;
        if (r < I_SQ) { p0_transpose_item(p.cd_w_out, 2048, 2048, (bf16_t*)(p.ws + OFF_WT_CDOUT), scr, r, lane); continue; } r -= I_SQ;
        if (r < I_SQ) { p0_transpose_item(p.peer_w_q, 2048, 2048, (bf16_t*)(p.ws + OFF_WT_PQ0), scr, r, lane); continue; } r -= I_SQ;
        p0_transpose_item(p.peer_w_q + (size_t)2048 * 2048, 2048, 2048, (bf16_t*)(p.ws + OFF_WT_PQ1), scr, r, lane);
    }
}

__device__ __forceinline__ void ph_mod(const Params& p, unsigned char* smem) {
    float* sc = (float*)smem;
    f32x4* red = (f32x4*)(smem + 16384);
    for (int i = TID(); i < 2048; i += NTHR) { sc[i] = siluf(p.c[i]); sc[2048 + i] = siluf(p.c_ctx[i]); }
    __syncthreads();
    float* modv = (float*)(p.ws + OFF_MODV);
    const int lane = TID() & 63, wave = TID() >> 6, cl = lane & 31, kp = lane >> 5;
    constexpr int C4 = 3072;
    for (int u = blockIdx.x; u < 2 * 96; u += gridDim.x) {
        const int l = u / 96, c4 = (u % 96) * 32 + cl;
        const f32x4* W = (const f32x4*)(p.mod_w + (size_t)l * 2048 * 12288) + c4;
        f32x4 a0 = {0.f, 0.f, 0.f, 0.f}, a1 = {0.f, 0.f, 0.f, 0.f};
        const int k0 = wave * 256 + kp;
#pragma unroll 8
        for (int k = k0; k < k0 + 256; k += 2) { const f32x4 w = __builtin_nontemporal_load(&W[(size_t)k * C4]); a0 += w * sc[k]; a1 += w * sc[2048 + k]; }
#pragma unroll
        for (int e = 0; e < 4; ++e) { a0[e] += __shfl_xor(a0[e], 32); a1[e] += __shfl_xor(a1[e], 32); }
        if (kp == 0) { red[wave * 32 + cl] = a0; red[256 + wave * 32 + cl] = a1; }
        __syncthreads();
        if (wave < 2 && kp == 0) {
            f32x4 sm = *((const f32x4*)(p.mod_b + (size_t)l * 12288) + c4);
#pragma unroll
            for (int w = 0; w < 8; ++w) sm += red[wave * 256 + w * 32 + cl];
            *(f32x4*)(modv + (size_t)(l * 2 + wave) * 12288 + c4 * 4) = sm;
        }
        __syncthreads();
    }
}

__device__ __forceinline__ void conv_table_rows(const Params& p, int row_lo, int row_hi, int part, int nparts);
constexpr int TAIL_RPB_AB = 128, TAIL_RPB_CD = 56;
__device__ __forceinline__ int tail_rows(int nwg, int rpb) { const int G = (int)gridDim.x, rem = nwg % G; return rem ? (G - rem) * rpb : 0; }
__device__ __forceinline__ void tail_conv(const Params& p, int nwg, int rpb, int row_end) { const int G = (int)gridDim.x, rem = nwg % G; if (rem && (int)blockIdx.x >= rem) conv_table_rows(p, row_end - (G - rem) * rpb, row_end, (int)blockIdx.x - rem, G - rem); }
__device__ __forceinline__ void ph_conv_tables(const Params& p) {
    const int lane = TID() & 63, wave = TID() >> 6;
    {   bf16_t* KEYSB = (bf16_t*)(p.ws + OFF_KEYSB);
        for (int i = blockIdx.x * NTHR + TID(); i < 2 * 8 * 2 * 128 * 128 / 4; i += gridDim.x * NTHR) { const f32x4 v = ((const f32x4*)p.peer_sub_keys)[i]; u32x2 o; o.x = pk2(v.x, v.y); o.y = pk2(v.z, v.w); ((u32x2*)KEYSB)[i] = o; } }
    conv_table_rows(p, 0, 2 * 16384 - tail_rows(33 * 29, TAIL_RPB_AB), (int)blockIdx.x, (int)gridDim.x);
}
__device__ __forceinline__ void conv_table_rows(const Params& p, int row_lo, int row_hi, int part, int nparts) {
    const int lane = TID() & 63, wave = TID() >> 6;
    const int stride = nparts * 8;
#define CT_LOAD(V, r_) do { const int rr_ = min((int)(r_), row_hi - 1); const int t_ = rr_ >> 14, e_ = rr_ & 16383; \
        const f32x4* src_ = (const f32x4*)(((t_ & 1) ? p.peer_v : p.peer_u) + ((size_t)(t_ >> 1) * 16384 + e_) * 2048); \
        _Pragma("unroll") for (int j = 0; j < 8; ++j) V[j] = __builtin_nontemporal_load(&src_[lane + 64 * j]); } while (0)
#define CT_PROC(V, r_) do { if ((r_) < row_hi) { const int t = (r_) >> 14, e = (r_) & 16383; float am = 0.f; \
        _Pragma("unroll") for (int j = 0; j < 8; ++j) am = fmaxf(am, fmaxf(fmaxf(fabsf(V[j].x), fabsf(V[j].y)), fmaxf(fabsf(V[j].z), fabsf(V[j].w)))); \
        am = fmaxf(am, 1e-30f); \
        const float sc = bf2f((bf16_t)f2bf(am * (1.f / 7.f))); const float inv = frcp(sc); \
          \
        const int qoff = (t & 1) ? 8 : 0; \
        u32 w[4]; \
        _Pragma("unroll") for (int d = 0; d < 4; ++d) { const f32x4 a = V[2 * d], b = V[2 * d + 1]; \
            const int q0 = min(max((int)rintf(a.x * inv), -7), 7) + qoff, q1 = min(max((int)rintf(a.y * inv), -7), 7) + qoff, q2 = min(max((int)rintf(a.z * inv), -7), 7) + qoff, q3 = min(max((int)rintf(a.w * inv), -7), 7) + qoff; \
            const int q4 = min(max((int)rintf(b.x * inv), -7), 7) + qoff, q5 = min(max((int)rintf(b.y * inv), -7), 7) + qoff, q6 = min(max((int)rintf(b.z * inv), -7), 7) + qoff, q7 = min(max((int)rintf(b.w * inv), -7), 7) + qoff; \
            w[d] = ((u32)q0 & 15u) | (((u32)q1 & 15u) << 4) | (((u32)q2 & 15u) << 8) | (((u32)q3 & 15u) << 12) | (((u32)q4 & 15u) << 16) | (((u32)q5 & 15u) << 20) | (((u32)q6 & 15u) << 24) | (((u32)q7 & 15u) << 28); } \
        unsigned char* tb = p.ws + (t == 0 ? OFF_TU0 : t == 1 ? OFF_TV0 : t == 2 ? OFF_TU1 : OFF_TV1); \
        __builtin_nontemporal_store((u32x4){w[0], w[1], w[2], w[3]}, (u32x4*)(tb + (size_t)e * 1024 + lane * 16)); \
        ((bf16_t*)(tb + 32 * MiB))[(size_t)e * 64 + lane] = (bf16_t)f2bf(sc); } } while (0)
    f32x4 va[8], vb[8];
    int row = row_lo + part * 8 + wave;
    CT_LOAD(va, row);
    for (; row < row_hi; row += 2 * stride) {
        CT_LOAD(vb, row + stride);
        CT_PROC(va, row);
        CT_LOAD(va, row + 2 * stride);
        CT_PROC(vb, row + stride);
    }
#undef CT_LOAD
#undef CT_PROC
}

__device__ __forceinline__ void ph_norm(const Params& p, int l, int a, const float* lat_src, const float* ctx_src, int nrows, bool write_q = false, const bf16_t* Y = nullptr, float* dst_lat = nullptr, float* dst_ctx = nullptr, bool write_i8 = false, bool write_h = true) {
    const int lane = TID() & 63, wave = TID() >> 6;
    const int gw = blockIdx.x * 8 + wave, NGW = gridDim.x * 8;
    const f32x4* g4 = (const f32x4*)(p.norm_g + (size_t)(l * 2 + a) * 2048);
    const float* modv = (const float*)(p.ws + OFF_MODV);
    bf16_t* H = (bf16_t*)(p.ws + OFF_H);
    for (int m = gw; m < nrows; m += NGW) {
        const bool isc = m >= NL;
        const f32x4* src = (const f32x4*)(isc ? ctx_src + (size_t)(m - NL) * DM : lat_src + (size_t)m * DM);
        const float* mv = modv + (size_t)(l * 2 + (isc ? 1 : 0)) * 12288 + (a ? 3 : 0) * 2048;
        const f32x4* sh4 = (const f32x4*)mv; const f32x4* sc4 = (const f32x4*)(mv + 2048);
        f32x4 v[8]; float ss = 0.f;
        if (Y) {
            const f32x4* gt4 = (const f32x4*)(modv + (size_t)(l * 2 + (isc ? 1 : 0)) * 12288 + 2 * 2048);
            const u32x2* y2 = (const u32x2*)(Y + (size_t)m * DM);
            f32x4* dst = (f32x4*)(isc ? dst_ctx + (size_t)(m - NL) * DM : dst_lat + (size_t)m * DM);
#pragma unroll
            for (int j = 0; j < 8; ++j) { const int i4 = lane + 64 * j; const u32x2 yy = y2[i4]; const f32x4 yf = {bfl(yy.x), bfh(yy.x), bfl(yy.y), bfh(yy.y)};
                v[j] = src[i4] + gt4[i4] * yf; __builtin_nontemporal_store(v[j], &dst[i4]); ss += v[j].x * v[j].x + v[j].y * v[j].y + v[j].z * v[j].z + v[j].w * v[j].w; }
        } else {
#pragma unroll
            for (int j = 0; j < 8; ++j) { v[j] = src[lane + 64 * j]; ss += v[j].x * v[j].x + v[j].y * v[j].y + v[j].z * v[j].z + v[j].w * v[j].w; }
        }
        ss = wave_sum(ss);
        const float r = rsqrtf(ss * (1.f / 2048.f) + 1e-6f);
        u32x2* o = (u32x2*)(H + (size_t)m * DM);
        float am = 0.f;
#pragma unroll
        for (int j = 0; j < 8; ++j) {
            const int i4 = lane + 64 * j; const f32x4 gg = g4[i4], sh = sh4[i4], sc = sc4[i4];
            const f32x4 y = v[j] * r * gg * (sc + 1.f) + sh; v[j] = y;
            am = fmaxf(am, fmaxf(fmaxf(fabsf(y.x), fabsf(y.y)), fmaxf(fabsf(y.z), fabsf(y.w))));
            if (write_h) { u32x2 w; w.x = pk2(y.x, y.y); w.y = pk2(y.z, y.w); o[i4] = w; }
        }
        if (write_i8) {
            const float am8 = fmaxf(wave_max(am), 1e-30f); const float inv8 = 127.f / am8;
            u32* o8 = (u32*)(p.ws + OFF_H8 + (size_t)m * DM);
#pragma unroll
            for (int j = 0; j < 8; ++j) __builtin_nontemporal_store(((u32)((int)rintf(v[j].x * inv8)) & 0xffu) | (((u32)((int)rintf(v[j].y * inv8)) & 0xffu) << 8) | (((u32)((int)rintf(v[j].z * inv8)) & 0xffu) << 16) | (((u32)((int)rintf(v[j].w * inv8)) & 0xffu) << 24), &o8[lane + 64 * j]);
            if (lane == 0) ((float*)(p.ws + OFF_HS8))[m] = am8 * (1.f / 127.f);
        }
        if (write_q) {
            am = fmaxf(wave_max(am), 1e-30f); const float inv = 119.f / am;
            u32* oq = (u32*)(p.ws + OFF_HQ + (size_t)m * DM);
            u32 xh[4], xl[4];
#pragma unroll
            for (int d = 0; d < 4; ++d) { xh[d] = 0u; xl[d] = 0u;
#pragma unroll
                for (int e = 0; e < 8; ++e) { const int x = (int)rintf(v[2 * d + (e >> 2)][e & 3] * inv); const int h_ = (x + 8) >> 4; const int l_ = x - 16 * h_;
                    xh[d] |= ((u32)h_ & 15u) << (4 * e); xl[d] |= ((u32)l_ & 15u) << (4 * e); } }
            __builtin_nontemporal_store((u32x4){xh[0], xh[1], xh[2], xh[3]}, (u32x4*)(oq + lane * 8)); __builtin_nontemporal_store((u32x4){xl[0], xl[1], xl[2], xl[3]}, (u32x4*)(oq + lane * 8 + 4));
            if (lane == 0) ((float*)(p.ws + OFF_HQS))[m] = am * (1.f / 119.f);
        }
    }
}

struct EpiStoreBf16 {
    bf16_t* O; int ld;
    __device__ __forceinline__ void operator()(int m, int n, f32x4 v) const { u32x2 w; w.x = pk2(v.x, v.y); w.y = pk2(v.z, v.w); *(u32x2*)(O + (size_t)m * ld + n) = w; }
};
struct EpiResidual {
    const float* xin_lat; const float* xin_ctx; float* xout_lat; float* xout_ctx; const float* gate_lat; const float* gate_ctx;
    __device__ __forceinline__ void operator()(int m, int n, f32x4 v) const {
        if (m < NL) { const f32x4 b = *(const f32x4*)(xin_lat + (size_t)m * DM + n), g = *(const f32x4*)(gate_lat + n); *(f32x4*)(xout_lat + (size_t)m * DM + n) = b + g * v; }
        else { const int mc = m - NL; const f32x4 b = *(const f32x4*)(xin_ctx + (size_t)mc * DM + n), g = *(const f32x4*)(gate_ctx + n); *(f32x4*)(xout_ctx + (size_t)mc * DM + n) = b + g * v; }
    }
};
template <class Epi>
__device__ __forceinline__ void ph_gemm_naive(const bf16_t* A, const float* W, int M, int N, const Epi& E, unsigned char* smem) {
    float* As = (float*)smem;
    float* Ws = As + 16 * 132;
    const int tid = TID(), ty = tid >> 4, tx = tid & 15;
    const int nTm = M / 128, nTn = N / 64, ntile = nTm * nTn;
    for (int t = blockIdx.x; t < ntile; t += gridDim.x) {
        const int tm = t % nTm, tn = t / nTm; const int m0 = tm * 128, n0 = tn * 64;
        f32x4 acc[4];
#pragma unroll
        for (int i = 0; i < 4; ++i) acc[i] = (f32x4){0.f, 0.f, 0.f, 0.f};
        for (int k0 = 0; k0 < 2048; k0 += 16) {
            { const int r = tid >> 2, kq = (tid & 3) * 4; const u32x2 a = *(const u32x2*)(A + (size_t)(m0 + r) * 2048 + k0 + kq);
              As[(kq + 0) * 132 + r] = __uint_as_float(a.x << 16); As[(kq + 1) * 132 + r] = __uint_as_float(a.x & 0xffff0000u);
              As[(kq + 2) * 132 + r] = __uint_as_float(a.y << 16); As[(kq + 3) * 132 + r] = __uint_as_float(a.y & 0xffff0000u); }
            { const int kk = tid >> 5, nn = (tid & 31) * 2; const float2 w = *(const float2*)(W + (size_t)(k0 + kk) * N + n0 + nn); Ws[kk * 64 + nn] = w.x; Ws[kk * 64 + nn + 1] = w.y; }
            __syncthreads();
#pragma unroll
            for (int k = 0; k < 16; ++k) {
                const f32x4 a = *(const f32x4*)(As + k * 132 + ty * 4); const f32x4 b = *(const f32x4*)(Ws + k * 64 + tx * 4);
                acc[0] += b * a.x; acc[1] += b * a.y; acc[2] += b * a.z; acc[3] += b * a.w;
            }
            __syncthreads();
        }
#pragma unroll
        for (int i = 0; i < 4; ++i) E(m0 + ty * 4 + i, n0 + tx * 4, acc[i]);
    }
}

__device__ __forceinline__ int tile_pos(int z, int tt);
__device__ __forceinline__ float wave_incl_scan(float v, int lane, float& total);
__device__ __forceinline__ void ph_prep_ab(const Params& p, unsigned char* smem) {
    const bf16_t* PAB = (const bf16_t*)(p.ws + OFF_PAB);
    bf16_t* AQ = (bf16_t*)(p.ws + OFF_AQ); bf16_t* AK = (bf16_t*)(p.ws + OFF_AK); bf16_t* AKT = (bf16_t*)(p.ws + OFF_AKT);
    bf16_t* AVT = (bf16_t*)(p.ws + OFF_AVT); bf16_t* BVT = (bf16_t*)(p.ws + OFF_BVT);
    const int tid = TID();
    {
        bf16_t* tK = (bf16_t*)smem; bf16_t* tV = tK + 64 * 128; bf16_t* tB = tV + 64 * 128;
        const int c16 = tid & 15, qk = (tid >> 4) & 1, tg = tid >> 5;
        for (int u = blockIdx.x; u < 132 * 8; u += gridDim.x) {
            const int tt = u >> 3, h = u & 7; const int m0 = tt * 64; const int lo = m0 < NL ? 0 : NL, hi = m0 < NL ? NL : NT;
            {
                const int ch0 = qk * 1024 + h * 128 + c16 * 8;
                float w0[8], w1[8], w2[8], bs[8];
#pragma unroll
                for (int q = 0; q < 2; ++q) { const f32x4 a0 = *(const f32x4*)(p.ab_conv_w + ch0 + q * 4), a1 = *(const f32x4*)(p.ab_conv_w + 2048 + ch0 + q * 4), a2 = *(const f32x4*)(p.ab_conv_w + 4096 + ch0 + q * 4), bb = *(const f32x4*)(p.ab_conv_b + ch0 + q * 4);
#pragma unroll
                    for (int e = 0; e < 4; ++e) { w0[q * 4 + e] = a0[e]; w1[q * 4 + e] = a1[e]; w2[q * 4 + e] = a2[e]; bs[q * 4 + e] = bb[e]; } }
                u32x4 rw[6];
#pragma unroll
                for (int i = 0; i < 6; ++i) { const int m = m0 + tg * 4 + i - 1; rw[i] = (m >= lo && m < hi) ? *(const u32x4*)(PAB + (size_t)m * PAB_LD + ch0) : (u32x4){0u, 0u, 0u, 0u}; }
                const float sc = qk ? 0.08838834764831845f : 1.f;
                bf16_t* dst = (qk ? AK : AQ) + ((size_t)h * NT + m0 + tg * 4) * 128 + c16 * 8;
#pragma unroll
                for (int i = 0; i < 4; ++i) {
                    float o[8];
#pragma unroll
                    for (int e2 = 0; e2 < 4; ++e2) {
                        const u32 xm = rw[i][e2], x0 = rw[i + 1][e2], xp = rw[i + 2][e2];
                        o[2 * e2] = siluf(w0[2 * e2] * bfl(xm) + w1[2 * e2] * bfl(x0) + w2[2 * e2] * bfl(xp) + bs[2 * e2]) * sc;
                        o[2 * e2 + 1] = siluf(w0[2 * e2 + 1] * bfh(xm) + w1[2 * e2 + 1] * bfh(x0) + w2[2 * e2 + 1] * bfh(xp) + bs[2 * e2 + 1]) * sc; }
                    u32x4 ov; ov.x = pk2(o[0], o[1]); ov.y = pk2(o[2], o[3]); ov.z = pk2(o[4], o[5]); ov.w = pk2(o[6], o[7]);
                    *(u32x4*)(dst + (size_t)i * 128) = ov;
                    if (qk) *(u32x4*)(tK + (tg * 4 + i) * 128 + c16 * 8) = ov;
                }
            }
#pragma unroll
            for (int i = 0; i < 2; ++i) { const int e = tid + NTHR * i; const int tau = e >> 4, c = e & 15;
                *(u32x4*)(tV + tau * 128 + c * 8) = *(const u32x4*)(PAB + (size_t)(m0 + tau) * PAB_LD + CA_V + h * 128 + c * 8);
                *(u32x4*)(tB + tau * 128 + c * 8) = *(const u32x4*)(PAB + (size_t)(m0 + tau) * PAB_LD + CB_V + h * 128 + c * 8); }
            __syncthreads();
            for (int e = tid; e < 128 * 8; e += NTHR) {
                const int d = e >> 3, c8 = e & 7;
                u32x4 ok, ov, ob; u32 tk[8], tv[8], tb[8];
#pragma unroll
                for (int j = 0; j < 8; ++j) { tk[j] = tK[(c8 * 8 + j) * 128 + d]; tv[j] = tV[(c8 * 8 + j) * 128 + d]; tb[j] = tB[(c8 * 8 + j) * 128 + d]; }
                ok.x = tk[0] | (tk[1] << 16); ok.y = tk[2] | (tk[3] << 16); ok.z = tk[4] | (tk[5] << 16); ok.w = tk[6] | (tk[7] << 16);
                ov.x = tv[0] | (tv[1] << 16); ov.y = tv[2] | (tv[3] << 16); ov.z = tv[4] | (tv[5] << 16); ov.w = tv[6] | (tv[7] << 16);
                ob.x = tb[0] | (tb[1] << 16); ob.y = tb[2] | (tb[3] << 16); ob.z = tb[4] | (tb[5] << 16); ob.w = tb[6] | (tb[7] << 16);
                *(u32x4*)(AKT + ((size_t)h * 128 + d) * NT + m0 + c8 * 8) = ok;
                *(u32x4*)(AVT + ((size_t)h * 144 + d) * NT + m0 + c8 * 8) = ov;
                *(u32x4*)(BVT + ((size_t)h * 128 + d) * NT + m0 + c8 * 8) = ob;
            }
            if (tid < 128) { const int rr = 128 + (tid >> 3), c8 = tid & 7; const u32 val = rr == 128 ? 0x3f803f80u : 0u;
                *(u32x4*)(AVT + ((size_t)h * 144 + rr) * NT + m0 + c8 * 8) = (u32x4){val, val, val, val}; }
            __syncthreads();
        }
    }
    {
        float* IG = (float*)(p.ws + OFF_IG); float* LF = (float*)(p.ws + OFF_LF);
        for (int i = blockIdx.x * NTHR + tid; i < NT * 32; i += gridDim.x * NTHR) {
            const int m = i >> 5, r = i & 31; const int z = r >> 4, g = (r >> 3) & 1, h = r & 7;
            const float val = bf2f(PAB[(size_t)m * PAB_LD + CA_G + r]) + p.ab_gate_b[r];
            if (g == 0) IG[(size_t)(z * 8 + h) * NT + m] = val; else LF[(size_t)(z * 8 + h) * NT + m] = logsigf(val);
        }
    }
    {
        bf16_t* BQS = (bf16_t*)(p.ws + OFF_BQS); bf16_t* BKS = (bf16_t*)(p.ws + OFF_BKS); bf16_t* BKST = (bf16_t*)(p.ws + OFF_BKENDT);
        float* GDEC = (float*)(p.ws + OFF_GDEC);
        const int lane = tid & 63, wv = __builtin_amdgcn_readfirstlane(tid >> 6);
        float awr[16][8], abr[8]; int zcur = -1, c0cur = -1;
        for (int job = ((int)gridDim.x - 1 - (int)blockIdx.x) * 8 + wv; job < 2 * 132 * 64; job += gridDim.x * 8) {
            const int z = job / (132 * 64), r = job % (132 * 64), tt = r >> 6, c0 = (r & 63) * 8, h = c0 >> 6; const int m = tt * 64 + lane;
            const bf16_t* row = PAB + (size_t)m * PAB_LD;
            const u32x4 lr0 = *(const u32x4*)(row + CB_LR + z * 16), lr1 = *(const u32x4*)(row + CB_LR + z * 16 + 8);
            const u32x4 qv = *(const u32x4*)(row + CB_Q + c0), kv = *(const u32x4*)(row + CB_K + c0);
            const float x[16] = {bfl(lr0.x), bfh(lr0.x), bfl(lr0.y), bfh(lr0.y), bfl(lr0.z), bfh(lr0.z), bfl(lr0.w), bfh(lr0.w), bfl(lr1.x), bfh(lr1.x), bfl(lr1.y), bfh(lr1.y), bfl(lr1.z), bfh(lr1.z), bfl(lr1.w), bfh(lr1.w)};
            if (z != zcur || c0 != c0cur) {
#pragma unroll
                for (int rr = 0; rr < 16; ++rr) { const f32x4 a0 = *(const f32x4*)(p.ab_alpha_w2 + (size_t)(z * 16 + rr) * 512 + c0), a1 = *(const f32x4*)(p.ab_alpha_w2 + (size_t)(z * 16 + rr) * 512 + c0 + 4);
                    awr[rr][0] = a0.x; awr[rr][1] = a0.y; awr[rr][2] = a0.z; awr[rr][3] = a0.w; awr[rr][4] = a1.x; awr[rr][5] = a1.y; awr[rr][6] = a1.z; awr[rr][7] = a1.w; }
                { const f32x4 b0 = *(const f32x4*)(p.ab_alpha_b + z * 512 + c0), b1 = *(const f32x4*)(p.ab_alpha_b + z * 512 + c0 + 4);
                  abr[0] = b0.x; abr[1] = b0.y; abr[2] = b0.z; abr[3] = b0.w; abr[4] = b1.x; abr[5] = b1.y; abr[6] = b1.z; abr[7] = b1.w; }
                zcur = z; c0cur = c0;
            }
            float za[8];
#pragma unroll
            for (int j = 0; j < 8; ++j) za[j] = abr[j];
#pragma unroll
            for (int rr = 0; rr < 16; ++rr)
#pragma unroll
                for (int j = 0; j < 8; ++j) za[j] += x[rr] * awr[rr][j];
            const float qf[8] = {bfl(qv.x), bfh(qv.x), bfl(qv.y), bfh(qv.y), bfl(qv.z), bfh(qv.z), bfl(qv.w), bfh(qv.w)};
            const float kf[8] = {bfl(kv.x), bfh(kv.x), bfl(kv.y), bfh(kv.y), bfl(kv.z), bfh(kv.z), bfl(kv.w), bfh(kv.w)};
            float qo[8], ko[8], tots[8];
#pragma unroll
            for (int j = 0; j < 8; ++j) {
                const float lg = -__logf(1.f + __expf(-za[j])) * (1.f / 16.f);
                float tot; const float pre = wave_incl_scan(lg, lane, tot); const float run = z ? tot - pre + lg : pre;
                qo[j] = qf[j] * 0.125f * __expf(run); ko[j] = kf[j] * __expf(-run); tots[j] = tot;
            }
            u32x4 oq, ok; oq.x = pk2(qo[0], qo[1]); oq.y = pk2(qo[2], qo[3]); oq.z = pk2(qo[4], qo[5]); oq.w = pk2(qo[6], qo[7]);
            ok.x = pk2(ko[0], ko[1]); ok.y = pk2(ko[2], ko[3]); ok.z = pk2(ko[4], ko[5]); ok.w = pk2(ko[6], ko[7]);
            *(u32x4*)(BQS + ((size_t)(z * 8 + h) * NT + m) * 64 + (c0 & 63)) = oq;
            *(u32x4*)(BKS + ((size_t)(z * 8 + h) * NT + m) * 64 + (c0 & 63)) = ok;
#pragma unroll
            for (int j = 0; j < 8; ++j) BKST[((size_t)(z * 8 + h) * 64 + (c0 & 63) + j) * NT + m] = (bf16_t)(j & 1 ? (((j >> 1) == 0 ? ok.x : (j >> 1) == 1 ? ok.y : (j >> 1) == 2 ? ok.z : ok.w) >> 16) : (((j >> 1) == 0 ? ok.x : (j >> 1) == 1 ? ok.y : (j >> 1) == 2 ? ok.z : ok.w) & 0xffffu));
            if (lane < 8) { float tv = tots[0];
#pragma unroll
                for (int j = 1; j < 8; ++j) tv = lane == j ? tots[j] : tv;
                GDEC[((size_t)(z * 8 + h) * 132 + tile_pos(z, tt)) * 64 + (c0 & 63) + lane] = __expf(tv); }
        }
    }
}

__device__ __forceinline__ int unit_kind(int u) { return (u + (u >> 8)) & 1; }
__device__ __forceinline__ int tile_pos(int z, int tt) { if (tt < 128) return z == 0 ? 4 + tt : 4 + (127 - tt); const int c = tt - 128; return z == 0 ? c : 3 - c; }
typedef short bf16x8_t __attribute__((ext_vector_type(8)));
#define MFMA16(a, b, c) __builtin_amdgcn_mfma_f32_16x16x32_bf16(a, b, c, 0, 0, 0)
__device__ __forceinline__ bf16x8_t ld8(const bf16_t* q) { return *(const bf16x8_t*)q; }
template <int N> __device__ __forceinline__ float row_shr_z(float v) { return __int_as_float(__builtin_amdgcn_update_dpp(0, __float_as_int(v), 0x110 | N, 0xF, 0xF, true)); }
__device__ __forceinline__ float wave_incl_scan(float v, int lane, float& total) {
    v += row_shr_z<1>(v); v += row_shr_z<2>(v); v += row_shr_z<4>(v); v += row_shr_z<8>(v);
    const float t0 = __int_as_float(__builtin_amdgcn_readlane(__float_as_int(v), 15)), t1 = __int_as_float(__builtin_amdgcn_readlane(__float_as_int(v), 31));
    const float t2 = __int_as_float(__builtin_amdgcn_readlane(__float_as_int(v), 47)), t3 = __int_as_float(__builtin_amdgcn_readlane(__float_as_int(v), 63));
    const int q = lane >> 4;
    v += (q >= 1 ? t0 : 0.f) + (q >= 2 ? t1 : 0.f) + (q >= 3 ? t2 : 0.f);
    total = ((t0 + t1) + t2) + t3;
    return v;
}

__device__ __forceinline__ void ph_sa(const Params& p, unsigned char* smem, int abl = 0) {
    const bf16_t* AKT = (const bf16_t*)(p.ws + OFF_AKT); const bf16_t* AVT = (const bf16_t*)(p.ws + OFF_AVT);
    const bf16_t* BVT = (const bf16_t*)(p.ws + OFF_BVT); const bf16_t* BKST = (const bf16_t*)(p.ws + OFF_BKENDT);
    const float* IG = (const float*)(p.ws + OFF_IG); const float* LF = (const float*)(p.ws + OFF_LF);
    bf16_t* DCT = (bf16_t*)(p.ws + OFF_DCT); bf16_t* DST = (bf16_t*)(p.ws + OFF_DST); float* DEC = (float*)(p.ws + OFF_DEC); const float* GDEC = (const float*)(p.ws + OFF_GDEC);
    const int tid = TID(), lane = tid & 63, wave = tid >> 6, lr = lane & 15, lq = lane >> 4;
    constexpr int T_V = 0, T_K = 144 * 144, BUF = 144 * 144 + 64 * 144;
    float* wl = (float*)(smem + 2 * BUF) + wave * 64;
    bf16x8_t kr[2], gv[2]; float lf = 0.f, ig = 0.f; f32x4 gd[4]; u32x4 st[4];
#define SA_DEC(u_) const int z_ = (u_) / 1056, r2_ = (u_) % 1056, h_ = r2_ / 132, tt_ = r2_ % 132; const int m0_ = tt_ * 64, zh_ = z_ * 8 + h_, pos_ = tile_pos(z_, tt_)
#define SA_LOADW(u_) do { SA_DEC(u_); lf = LF[(size_t)zh_ * NT + m0_ + lane]; ig = IG[(size_t)zh_ * NT + m0_ + lane]; \
        _Pragma("unroll") for (int ks = 0; ks < 2; ++ks) { kr[ks] = ld8(AKT + ((size_t)h_ * 128 + wave * 16 + lr) * NT + m0_ + ks * 32 + 8 * lq); gv[ks] = ld8(BVT + ((size_t)h_ * 128 + wave * 16 + lr) * NT + m0_ + ks * 32 + 8 * lq); } \
        _Pragma("unroll") for (int nt = 0; nt < 4; ++nt) gd[nt] = *(const f32x4*)(GDEC + (size_t)(zh_ * 132 + pos_) * 64 + nt * 16 + lq * 4); } while (0)
#define SA_LOADT(u_) do { SA_DEC(u_); (void)pos_; _Pragma("unroll") for (int i = 0; i < 3; ++i) { const int pc = min(tid + NTHR * i, 1151); st[i] = *(const u32x4*)(AVT + ((size_t)h_ * 144 + (pc >> 3)) * NT + m0_ + (pc & 7) * 8); } \
        st[3] = *(const u32x4*)(BKST + ((size_t)zh_ * 64 + (tid >> 3)) * NT + m0_ + (tid & 7) * 8); } while (0)
#define SA_STORET(bo) do { _Pragma("unroll") for (int i = 0; i < 3; ++i) { const int pc = tid + NTHR * i; if (pc < 1152) *(u32x4*)(smem + (bo) + T_V + (pc >> 3) * 144 + (pc & 7) * 16) = st[i]; } \
        *(u32x4*)(smem + (bo) + T_K + (tid >> 3) * 144 + (tid & 7) * 16) = st[3]; } while (0)
    const int u0 = min((int)blockIdx.x, 2111);
    SA_LOADT(u0); SA_LOADW(u0);
    __syncthreads();
    SA_STORET(0);
    __syncthreads();
    { const int u1 = min(u0 + (int)gridDim.x, 2111); SA_LOADT(u1); }
    int cnt = 0;
    for (int u = blockIdx.x; u < 2112; u += gridDim.x, ++cnt) {
        const int z = u / 1056, r2 = u % 1056, h = r2 / 132, tt = r2 % 132; const int pos = tile_pos(z, tt), zh = z * 8 + h;
        const unsigned char* Vl = smem + (cnt & 1) * BUF + T_V; const unsigned char* Kl = smem + (cnt & 1) * BUF + T_K;
        const float lf_ = lf, ig_ = ig; const bf16x8_t kr0 = kr[0], kr1 = kr[1], gv0 = gv[0], gv1 = gv[1]; const f32x4 gd0 = gd[0], gd1 = gd[1], gd2 = gd[2], gd3 = gd[3];
        { const int un = min(u + (int)gridDim.x, 2111); SA_LOADW(un); }
        float tot; const float pre = wave_incl_scan(lf_, lane, tot); const float b = z ? tot - pre + lf_ : pre;
        wl[lane] = __expf(tot - b + ig_);
        if (wave == 0 && lane == 0) DEC[zh * 132 + pos] = __expf(tot);
        bf16x8_t ka[2];
#pragma unroll
        for (int ks = 0; ks < 2; ++ks) {
            const bf16x8_t krr = ks ? kr1 : kr0;
            const f32x4 w0 = *(const f32x4*)(wl + ks * 32 + 8 * lq), w1 = *(const f32x4*)(wl + ks * 32 + 8 * lq + 4);
            const float wv[8] = {w0.x, w0.y, w0.z, w0.w, w1.x, w1.y, w1.z, w1.w};
            u32 pk[4];
#pragma unroll
            for (int j = 0; j < 4; ++j) pk[j] = pk2(bf2f((bf16_t)krr[2 * j]) * wv[2 * j], bf2f((bf16_t)krr[2 * j + 1]) * wv[2 * j + 1]);
            ka[ks] = __builtin_bit_cast(bf16x8_t, (u32x4){pk[0], pk[1], pk[2], pk[3]});
        }
        bf16_t* o = DCT + (size_t)(zh * 132 + pos) * (144 * 128) + (size_t)wave * (144 * 16) + lq * 4;
#pragma unroll
        for (int t9 = 0; t9 < 9; ++t9) { f32x4 acc = {0.f, 0.f, 0.f, 0.f};
#pragma unroll
            for (int ks = 0; ks < 2; ++ks) { const bf16x8_t vb = *(const bf16x8_t*)(Vl + (t9 * 16 + lr) * 144 + (ks * 32 + 8 * lq) * 2); acc = MFMA16(ka[ks], vb, acc); }
            u32x2 w; w.x = pk2(acc[0], acc[1]); w.y = pk2(acc[2], acc[3]); *(u32x2*)(o + (size_t)(t9 * 16 + lr) * 16) = w; }
        bf16_t* o2 = DST + (size_t)(zh * 132 + pos) * (128 * 64) + (size_t)(wave * 16 + lr) * 64 + lq * 4;
#pragma unroll
        for (int nt = 0; nt < 4; ++nt) { f32x4 acc = {0.f, 0.f, 0.f, 0.f};
#pragma unroll
            for (int ks = 0; ks < 2; ++ks) { const bf16x8_t kb = *(const bf16x8_t*)(Kl + (nt * 16 + lr) * 144 + (ks * 32 + 8 * lq) * 2); acc = MFMA16(kb, ks ? gv1 : gv0, acc); }
            acc *= (nt == 0 ? gd0 : nt == 1 ? gd1 : nt == 2 ? gd2 : gd3);
            u32x2 w; w.x = pk2(acc[0], acc[1]); w.y = pk2(acc[2], acc[3]); *(u32x2*)(o2 + nt * 16) = w; }
        SA_STORET(((cnt + 1) & 1) * BUF);
        __syncthreads();
        { const int u2 = min(u + 2 * (int)gridDim.x, 2111); SA_LOADT(u2); }
    }
#undef SA_DEC
#undef SA_LOADW
#undef SA_LOADT
#undef SA_STORET
}

__device__ __forceinline__ void ph_sb(const Params& p) {
    bf16_t* DCT = (bf16_t*)(p.ws + OFF_DCT); bf16_t* DST = (bf16_t*)(p.ws + OFF_DST); const float* DEC = (const float*)(p.ws + OFF_DEC); const float* GDEC = (const float*)(p.ws + OFF_GDEC);
    constexpr int NA = 16 * 4608, NB = 16 * 2048;
    for (int gt = blockIdx.x * NTHR + TID(); gt < NA + NB; gt += gridDim.x * NTHR) {
        if (gt < NA) {
            const int zh = gt / 4608, e4 = gt % 4608; bf16_t* ptr = DCT + (size_t)zh * 132 * 18432 + e4 * 4; const float* dec = DEC + zh * 132;
            float c0 = 0.f, c1 = 0.f, c2 = 0.f, c3 = 0.f;
            for (int q0 = 0; q0 < 132; q0 += 22) {
                u32x2 d[22]; float dc[22];
#pragma unroll
                for (int j = 0; j < 22; ++j) { d[j] = *(const u32x2*)(ptr + (size_t)(q0 + j) * 18432); dc[j] = dec[q0 + j]; }
#pragma unroll
                for (int j = 0; j < 22; ++j) { u32x2 o; o.x = pk2(c0, c1); o.y = pk2(c2, c3); *(u32x2*)(ptr + (size_t)(q0 + j) * 18432) = o;
                    c0 = dc[j] * c0 + __uint_as_float(d[j].x << 16); c1 = dc[j] * c1 + __uint_as_float(d[j].x & 0xffff0000u); c2 = dc[j] * c2 + __uint_as_float(d[j].y << 16); c3 = dc[j] * c3 + __uint_as_float(d[j].y & 0xffff0000u); }
            }
        } else {
            const int g = gt - NA; const int zh = g / 2048, e4 = g % 2048; const int dk0 = (e4 * 4) & 63; bf16_t* ptr = DST + (size_t)zh * 132 * 8192 + e4 * 4; const float* dec = GDEC + (size_t)zh * 132 * 64 + dk0;
            float c0 = 0.f, c1 = 0.f, c2 = 0.f, c3 = 0.f;
            for (int q0 = 0; q0 < 132; q0 += 22) {
                u32x2 d[22]; f32x4 dc[22];
#pragma unroll
                for (int j = 0; j < 22; ++j) { d[j] = *(const u32x2*)(ptr + (size_t)(q0 + j) * 8192); dc[j] = *(const f32x4*)(dec + (q0 + j) * 64); }
#pragma unroll
                for (int j = 0; j < 22; ++j) { u32x2 o; o.x = pk2(c0, c1); o.y = pk2(c2, c3); *(u32x2*)(ptr + (size_t)(q0 + j) * 8192) = o;
                    c0 = dc[j].x * c0 + __uint_as_float(d[j].x << 16); c1 = dc[j].y * c1 + __uint_as_float(d[j].x & 0xffff0000u); c2 = dc[j].z * c2 + __uint_as_float(d[j].y << 16); c3 = dc[j].w * c3 + __uint_as_float(d[j].y & 0xffff0000u); }
            }
        }
    }
}

struct ScTiles { static constexpr int O_Q = 0, O_K = 17408, O_V = 34816, O_C0 = 55552, O_C1 = 94720, O_P = 133888, O_BI = 150272, O_X = 55552;
                 static constexpr int G_Q0 = 0, G_Q1 = 9216, G_K0 = 18432, G_K1 = 27648, G_V = 36864, G_S0 = 55552, G_S1 = 73984; };
__device__ __forceinline__ void sc_prefetch(const Params& p, int kind, int h, int tt, int tid, u32x4 (&rg)[17]) {
    const int m0 = tt * 64;
    if (kind == 0) {
        const bf16_t* AQ = (const bf16_t*)(p.ws + OFF_AQ); const bf16_t* AK = (const bf16_t*)(p.ws + OFF_AK); const bf16_t* AVT = (const bf16_t*)(p.ws + OFF_AVT); const bf16_t* DCT = (const bf16_t*)(p.ws + OFF_DCT);
        const bf16_t* C0 = DCT + (size_t)(h * 132 + tile_pos(0, tt)) * (144 * 128); const bf16_t* C1 = DCT + (size_t)((8 + h) * 132 + tile_pos(1, tt)) * (144 * 128);
#pragma unroll
        for (int i = 0; i < 2; ++i) { const int pc = tid + NTHR * i; rg[i] = *(const u32x4*)(AQ + ((size_t)h * NT + m0 + (pc >> 4)) * 128 + (pc & 15) * 8); rg[2 + i] = *(const u32x4*)(AK + ((size_t)h * NT + m0 + (pc >> 4)) * 128 + (pc & 15) * 8); }
#pragma unroll
        for (int i = 0; i < 3; ++i) { const int pc = min(tid + NTHR * i, 1151); rg[4 + i] = *(const u32x4*)(AVT + ((size_t)h * 144 + (pc >> 3)) * NT + m0 + (pc & 7) * 8); }
#pragma unroll
        for (int i = 0; i < 5; ++i) { const int pc = min(tid + NTHR * i, 2063); const int dkt = pc / 258, rem = pc % 258; const size_t so = (size_t)(dkt * 144 + (rem >> 1)) * 16 + (rem & 1) * 8;
            rg[7 + i] = *(const u32x4*)(C0 + so); rg[12 + i] = *(const u32x4*)(C1 + so); }
    } else {
        const bf16_t* BQS = (const bf16_t*)(p.ws + OFF_BQS); const bf16_t* BKS = (const bf16_t*)(p.ws + OFF_BKS); const bf16_t* BVT = (const bf16_t*)(p.ws + OFF_BVT); const bf16_t* DST = (const bf16_t*)(p.ws + OFF_DST);
        const bf16_t* S0 = DST + (size_t)(h * 132 + tile_pos(0, tt)) * (128 * 64); const bf16_t* S1 = DST + (size_t)((8 + h) * 132 + tile_pos(1, tt)) * (128 * 64);
        { const int row = tid >> 3, c = tid & 7;
          rg[0] = *(const u32x4*)(BQS + ((size_t)h * NT + m0 + row) * 64 + c * 8); rg[1] = *(const u32x4*)(BQS + ((size_t)(8 + h) * NT + m0 + row) * 64 + c * 8);
          rg[2] = *(const u32x4*)(BKS + ((size_t)h * NT + m0 + row) * 64 + c * 8); rg[3] = *(const u32x4*)(BKS + ((size_t)(8 + h) * NT + m0 + row) * 64 + c * 8); }
#pragma unroll
        for (int i = 0; i < 2; ++i) { const int pc = tid + NTHR * i; const int row = pc >> 3, c = pc & 7;
            rg[4 + i] = *(const u32x4*)(BVT + ((size_t)h * 128 + row) * NT + m0 + c * 8); rg[6 + i] = *(const u32x4*)(S0 + (size_t)row * 64 + c * 8); rg[8 + i] = *(const u32x4*)(S1 + (size_t)row * 64 + c * 8); }
#pragma unroll
        for (int i = 10; i < 17; ++i) rg[i] = (u32x4){0u, 0u, 0u, 0u};
    }
}
__device__ __forceinline__ void sc_store(unsigned char* smem, int kind, int tid, const u32x4 (&rg)[17]) {
    if (kind == 0) {
#pragma unroll
        for (int i = 0; i < 2; ++i) { const int pc = tid + NTHR * i; *(u32x4*)(smem + ScTiles::O_Q + (pc >> 4) * 272 + (pc & 15) * 16) = rg[i]; *(u32x4*)(smem + ScTiles::O_K + (pc >> 4) * 272 + (pc & 15) * 16) = rg[2 + i]; }
#pragma unroll
        for (int i = 0; i < 3; ++i) { const int pc = tid + NTHR * i; if (pc < 1152) *(u32x4*)(smem + ScTiles::O_V + (pc >> 3) * 144 + (pc & 7) * 16) = rg[4 + i]; }
#pragma unroll
        for (int i = 0; i < 5; ++i) { const int pc = tid + NTHR * i; if (pc < 2064) { const int dkt = pc / 258, rem = pc % 258; const int lo_ = (rem >> 1) * 272 + dkt * 32 + (rem & 1) * 16;
            *(u32x4*)(smem + ScTiles::O_C0 + lo_) = rg[7 + i]; *(u32x4*)(smem + ScTiles::O_C1 + lo_) = rg[12 + i]; } }
    } else {
        { const int row = tid >> 3, c = tid & 7;
          *(u32x4*)(smem + ScTiles::G_Q0 + row * 144 + c * 16) = rg[0]; *(u32x4*)(smem + ScTiles::G_Q1 + row * 144 + c * 16) = rg[1];
          *(u32x4*)(smem + ScTiles::G_K0 + row * 144 + c * 16) = rg[2]; *(u32x4*)(smem + ScTiles::G_K1 + row * 144 + c * 16) = rg[3]; }
#pragma unroll
        for (int i = 0; i < 2; ++i) { const int pc = tid + NTHR * i; const int row = pc >> 3, c = pc & 7;
            *(u32x4*)(smem + ScTiles::G_V + row * 144 + c * 16) = rg[4 + i]; *(u32x4*)(smem + ScTiles::G_S0 + row * 144 + c * 16) = rg[6 + i]; *(u32x4*)(smem + ScTiles::G_S1 + row * 144 + c * 16) = rg[8 + i]; }
    }
}
__device__ __forceinline__ void ph_sc(const Params& p, unsigned char* smem) {
    const bf16_t* PAB = (const bf16_t*)(p.ws + OFF_PAB);
    const float* IG = (const float*)(p.ws + OFF_IG); const float* LF = (const float*)(p.ws + OFF_LF);
    bf16_t* YM = (bf16_t*)(p.ws + OFF_YM);
    const int tid = TID(), lane = tid & 63, wave = tid >> 6, lr = lane & 15, lq = lane >> 4;
    const int z = wave >> 2, mt = wave & 3, t0 = mt * 16;
    constexpr int O_Q = ScTiles::O_Q, O_K = ScTiles::O_K, O_V = ScTiles::O_V, O_C0 = ScTiles::O_C0, O_C1 = ScTiles::O_C1, O_P = ScTiles::O_P, O_BI = ScTiles::O_BI, O_X = ScTiles::O_X;
    constexpr int G_Q0 = ScTiles::G_Q0, G_Q1 = ScTiles::G_Q1, G_K0 = ScTiles::G_K0, G_K1 = ScTiles::G_K1, G_V = ScTiles::G_V, G_S0 = ScTiles::G_S0, G_S1 = ScTiles::G_S1;
    bf16_t* Pt = (bf16_t*)(smem + O_P) + wave * (16 * 64);
    float* bi = (float*)(smem + O_BI) + wave * 128;
    float* X = (float*)(smem + O_X);
    u32x4 rg[17];
    float lfn, ign;
    { const int u0 = min((int)blockIdx.x, 2111); sc_prefetch(p, unit_kind(u0), (u0 >> 1) / 132, (u0 >> 1) % 132, tid, rg);
      const size_t o_ = (size_t)(z * 8 + (u0 >> 1) / 132) * NT + ((u0 >> 1) % 132) * 64 + lane; lfn = LF[o_]; ign = IG[o_]; }
    for (int u = blockIdx.x; u < 2112; u += gridDim.x) {
        const int kind = unit_kind(u), r = u >> 1; const int h = r / 132, tt = r % 132; const int m0 = tt * 64;
        __syncthreads();
        sc_store(smem, kind, tid, rg);
        f32x4 hv[8];
        const float lf = lfn, ig = ign;
        { const int un = min(u + (int)gridDim.x, 2111); sc_prefetch(p, unit_kind(un), (un >> 1) / 132, (un >> 1) % 132, tid, rg);
          const size_t o_ = (size_t)(z * 8 + (un >> 1) / 132) * NT + ((un >> 1) % 132) * 64 + lane; lfn = LF[o_]; ign = IG[o_]; }
        const int gcol = kind == 0 ? CA_O : CB_R; const int ycol = kind == 0 ? 0 : 1024; const float* hg = p.ab_head_g + kind * 128;
        u32x4 gt_[2];
#pragma unroll
        for (int i = 0; i < 2; ++i) { const int e = tid + NTHR * i; gt_[i] = *(const u32x4*)(PAB + (size_t)(m0 + (e >> 4)) * PAB_LD + gcol + h * 128 + (e & 15) * 8); }
        const f32x4 g0 = *(const f32x4*)(hg + (tid & 15) * 8), g1 = *(const f32x4*)(hg + (tid & 15) * 8 + 4);
        if (kind == 0) {
            float tot; const float pre = wave_incl_scan(lf, lane, tot); const float b = z ? tot - pre + lf : pre;
            bi[lane] = b; bi[64 + lane] = ig;
            __syncthreads();
            bf16x8_t qa[4];
#pragma unroll
            for (int ks = 0; ks < 4; ++ks) qa[ks] = *(const bf16x8_t*)(smem + O_Q + (t0 + lr) * 272 + (ks * 32 + 8 * lq) * 2);
            const f32x4 bt4 = *(const f32x4*)(bi + t0 + lq * 4);
#pragma unroll
            for (int nt = 0; nt < 4; ++nt) {
                f32x4 sacc = {0.f, 0.f, 0.f, 0.f};
#pragma unroll
                for (int ks = 0; ks < 4; ++ks) { const bf16x8_t kb = *(const bf16x8_t*)(smem + O_K + (nt * 16 + lr) * 272 + (ks * 32 + 8 * lq) * 2); sacc = MFMA16(qa[ks], kb, sacc); }
                const int sidx = nt * 16 + lr; const float bs = bi[sidx], is = bi[64 + sidx];
#pragma unroll
                for (int rg_ = 0; rg_ < 4; ++rg_) { const int t = t0 + lq * 4 + rg_; const bool keep = z ? (sidx >= t) : (sidx <= t);
                    const float val = keep ? sacc[rg_] * __expf(bt4[rg_] - bs + is) : 0.f; Pt[(lq * 4 + rg_) * 64 + sidx] = (bf16_t)f2bf(val); }
            }
            bf16x8_t pa[2];
#pragma unroll
            for (int ks = 0; ks < 2; ++ks) pa[ks] = *(const bf16x8_t*)(Pt + lr * 64 + ks * 32 + 8 * lq);
            const float e0 = __expf(bt4[0]), e1 = __expf(bt4[1]), e2 = __expf(bt4[2]), e3 = __expf(bt4[3]);
            const unsigned char* CT = smem + (z ? O_C1 : O_C0);
            f32x4 num[9];
#pragma unroll
            for (int nt = 0; nt < 9; ++nt) {
                f32x4 ai = {0.f, 0.f, 0.f, 0.f}, ac = {0.f, 0.f, 0.f, 0.f};
#pragma unroll
                for (int ks = 0; ks < 2; ++ks) { const bf16x8_t vb = *(const bf16x8_t*)(smem + O_V + (nt * 16 + lr) * 144 + (ks * 32 + 8 * lq) * 2); ai = MFMA16(pa[ks], vb, ai); }
#pragma unroll
                for (int ks = 0; ks < 4; ++ks) { const bf16x8_t cb = *(const bf16x8_t*)(CT + (nt * 16 + lr) * 272 + (ks * 32 + 8 * lq) * 2); ac = MFMA16(qa[ks], cb, ac); }
                num[nt] = (f32x4){ai[0] + e0 * ac[0], ai[1] + e1 * ac[1], ai[2] + e2 * ac[2], ai[3] + e3 * ac[3]};
            }
            f32x4 dn;
#pragma unroll
            for (int rg_ = 0; rg_ < 4; ++rg_) { const float d = __shfl(num[8][rg_], lane & 48); dn[rg_] = 1.f / fmaxf(fabsf(d), 1.f); }
#pragma unroll
            for (int nt = 0; nt < 8; ++nt) hv[nt] = num[nt] * dn;
        } else {
            __syncthreads();
            const unsigned char* Ql = smem + (z ? G_Q1 : G_Q0); const unsigned char* Kl = smem + (z ? G_K1 : G_K0); const unsigned char* Sl = smem + (z ? G_S1 : G_S0);
            bf16x8_t qa[2];
#pragma unroll
            for (int ks = 0; ks < 2; ++ks) qa[ks] = *(const bf16x8_t*)(Ql + (t0 + lr) * 144 + (ks * 32 + 8 * lq) * 2);
#pragma unroll
            for (int nt = 0; nt < 4; ++nt) {
                f32x4 sacc = {0.f, 0.f, 0.f, 0.f};
#pragma unroll
                for (int ks = 0; ks < 2; ++ks) { const bf16x8_t kb = *(const bf16x8_t*)(Kl + (nt * 16 + lr) * 144 + (ks * 32 + 8 * lq) * 2); sacc = MFMA16(qa[ks], kb, sacc); }
                const int sidx = nt * 16 + lr;
#pragma unroll
                for (int rg_ = 0; rg_ < 4; ++rg_) { const int t = t0 + lq * 4 + rg_; const bool keep = z ? (sidx >= t) : (sidx <= t); Pt[(lq * 4 + rg_) * 64 + sidx] = (bf16_t)f2bf(keep ? sacc[rg_] : 0.f); }
            }
            bf16x8_t pa[2];
#pragma unroll
            for (int ks = 0; ks < 2; ++ks) pa[ks] = *(const bf16x8_t*)(Pt + lr * 64 + ks * 32 + 8 * lq);
#pragma unroll
            for (int nt = 0; nt < 8; ++nt) {
                f32x4 acc = {0.f, 0.f, 0.f, 0.f};
#pragma unroll
                for (int ks = 0; ks < 2; ++ks) { const bf16x8_t vb = *(const bf16x8_t*)(smem + G_V + (nt * 16 + lr) * 144 + (ks * 32 + 8 * lq) * 2); acc = MFMA16(pa[ks], vb, acc); }
#pragma unroll
                for (int ks = 0; ks < 2; ++ks) { const bf16x8_t sb = *(const bf16x8_t*)(Sl + (nt * 16 + lr) * 144 + (ks * 32 + 8 * lq) * 2); acc = MFMA16(qa[ks], sb, acc); }
                hv[nt] = acc;
            }
        }
        __syncthreads();
        if (z == 1) {
#pragma unroll
            for (int nt = 0; nt < 8; ++nt)
#pragma unroll
                for (int rg = 0; rg < 4; ++rg) X[(mt * 16 + lq * 4 + rg) * 128 + nt * 16 + lr] = hv[nt][rg];
        }
        __syncthreads();
        if (z == 0) {
            f32x4 ss = {0.f, 0.f, 0.f, 0.f};
#pragma unroll
            for (int nt = 0; nt < 8; ++nt) {
#pragma unroll
                for (int rg = 0; rg < 4; ++rg) hv[nt][rg] += X[(mt * 16 + lq * 4 + rg) * 128 + nt * 16 + lr];
                ss += hv[nt] * hv[nt]; }
#pragma unroll
            for (int rg = 0; rg < 4; ++rg) { float v = ss[rg]; v += __shfl_xor(v, 1); v += __shfl_xor(v, 2); v += __shfl_xor(v, 4); v += __shfl_xor(v, 8); ss[rg] = rsqrtf(v * (1.f / 128.f) + 1e-6f); }
#pragma unroll
            for (int nt = 0; nt < 8; ++nt)
#pragma unroll
                for (int rg = 0; rg < 4; ++rg) X[(mt * 16 + lq * 4 + rg) * 128 + nt * 16 + lr] = hv[nt][rg] * ss[rg];
        }
        __syncthreads();
        {
#pragma unroll
            for (int i = 0; i < 2; ++i) { const int e = tid + NTHR * i; const int row = e >> 4, c = e & 15;
                const f32x4 x0 = *(const f32x4*)(X + row * 128 + c * 8), x1 = *(const f32x4*)(X + row * 128 + c * 8 + 4);
                const u32x4 gt = gt_[i];
                float gv[8] = {bfl(gt.x), bfh(gt.x), bfl(gt.y), bfh(gt.y), bfl(gt.z), bfh(gt.z), bfl(gt.w), bfh(gt.w)};
#pragma unroll
                for (int j = 0; j < 8; ++j) gv[j] = kind == 0 ? sigmoidf_(gv[j]) : siluf(gv[j]);
                u32x4 ov; ov.x = pk2(x0[0] * g0[0] * gv[0], x0[1] * g0[1] * gv[1]); ov.y = pk2(x0[2] * g0[2] * gv[2], x0[3] * g0[3] * gv[3]);
                ov.z = pk2(x1[0] * g1[0] * gv[4], x1[1] * g1[1] * gv[5]); ov.w = pk2(x1[2] * g1[2] * gv[6], x1[3] * g1[3] * gv[7]);
                *(u32x4*)(YM + (size_t)(m0 + row) * DM + ycol + h * 128 + c * 8) = ov; }
        }
    }
}

__device__ __forceinline__ u32 ord_key(float s) { const u32 u = __float_as_uint(s); return (u & 0x80000000u) ? ~u : (u | 0x80000000u); }
__device__ __forceinline__ float ord_val(u32 o) { const u32 u = (o & 0x80000000u) ? (o ^ 0x80000000u) : ~o; return __uint_as_float(u); }
template <int N> __device__ __forceinline__ u32 row_ror(u32 v) { return (u32)__builtin_amdgcn_update_dpp(0, (int)v, 0x120 | N, 0xF, 0xF, false); }
__device__ __forceinline__ u32 umax(u32 a, u32 b) { return a > b ? a : b; }
__device__ __forceinline__ u32 umin(u32 a, u32 b) { return a < b ? a : b; }
__device__ __forceinline__ u32 row_allmax(u32 v) { v = umax(v, row_ror<8>(v)); v = umax(v, row_ror<4>(v)); v = umax(v, row_ror<2>(v)); v = umax(v, row_ror<1>(v)); return v; }
#define CEX(i, j) { const u32 hi_ = umax(k[i], k[j]), lo_ = umin(k[i], k[j]); k[i] = hi_; k[j] = lo_; }
__device__ __forceinline__ void ph_route(const Params& p, int l, int nrows, unsigned char* smem) {
    const bf16_t* QP = (const bf16_t*)(p.ws + OFF_QP); const bf16_t* KEYSB = (const bf16_t*)(p.ws + OFF_KEYSB); int* EIDX = (int*)(p.ws + OFF_EIDX); float* EG = (float*)(p.ws + OFF_EG);
    const int tid = TID(), lane = tid & 63, wave = tid >> 6, lr = lane & 15, lq = lane >> 4;
    float* SC = (float*)smem;
    float* TOPV = (float*)(smem + 65536);
    int* TOPI = (int*)(smem + 65536 + 8192);
    unsigned char* KL = smem + 81920;
    int cur_head = -1;
    int ca[4], cb[4];
#pragma unroll
    for (int q = 0; q < 4; ++q) { int c = lr + 16 * q, a_ = 0, off = 0;
        for (int a2 = 0; a2 < 16; ++a2) { const int nb = 16 / (a2 + 1); if (c >= off && c < off + nb) { a_ = a2; break; } off += nb; }
        ca[q] = a_; cb[q] = c - off; if (c >= 50) { ca[q] = 0; cb[q] = 0; } }
    const bool c3ok = (lr + 48) < 50;
    const int ntile = nrows / 64;
    for (int u = blockIdx.x; u < ntile * 8; u += gridDim.x) {
        const int tt = u >> 3, head = u & 7; const int m0 = tt * 64;
        if (head != cur_head) {
            __syncthreads();
#pragma unroll
            for (int i = 0; i < 8; ++i) { const int pc = tid + NTHR * i; const int row = pc >> 4, c = pc & 15;
                *(u32x4*)(KL + row * 272 + c * 16) = *(const u32x4*)(KEYSB + ((size_t)(l * 8 + head) * 256 + row) * 128 + c * 8); }
            cur_head = head;
            __syncthreads();
        }
        {
            const int z = wave >> 2, mt = wave & 3;
            bf16x8_t qa[4];
#pragma unroll
            for (int ks = 0; ks < 4; ++ks) qa[ks] = ld8(QP + (size_t)(m0 + mt * 16 + lr) * DM + head * 256 + z * 128 + ks * 32 + 8 * lq);
            const unsigned char* kb = KL + (z * 128) * 272;
#pragma unroll
            for (int nt = 0; nt < 8; ++nt) { f32x4 acc = {0.f, 0.f, 0.f, 0.f};
#pragma unroll
                for (int ks = 0; ks < 4; ++ks) { const bf16x8_t bb = *(const bf16x8_t*)(kb + (nt * 16 + lr) * 272 + (ks * 32 + 8 * lq) * 2); acc = MFMA16(qa[ks], bb, acc); }
#pragma unroll
                for (int rg = 0; rg < 4; ++rg) SC[(z * 64 + mt * 16 + lq * 4 + rg) * 128 + nt * 16 + lr] = acc[rg]; }
        }
        __syncthreads();
        for (int rd = 0; rd < 4; ++rd) {
            const int pi = rd * 32 + wave * 4 + lq; const int z = pi >> 6, t = pi & 63;
            const f32x4 s0 = *(const f32x4*)(SC + (z * 64 + t) * 128 + lr * 8), s1 = *(const f32x4*)(SC + (z * 64 + t) * 128 + lr * 8 + 4);
            u32 k[8];
            k[0] = (ord_key(s0.x) & ~0x7fu) | (u32)(127 - (lr * 8 + 0)); k[1] = (ord_key(s0.y) & ~0x7fu) | (u32)(127 - (lr * 8 + 1));
            k[2] = (ord_key(s0.z) & ~0x7fu) | (u32)(127 - (lr * 8 + 2)); k[3] = (ord_key(s0.w) & ~0x7fu) | (u32)(127 - (lr * 8 + 3));
            k[4] = (ord_key(s1.x) & ~0x7fu) | (u32)(127 - (lr * 8 + 4)); k[5] = (ord_key(s1.y) & ~0x7fu) | (u32)(127 - (lr * 8 + 5));
            k[6] = (ord_key(s1.z) & ~0x7fu) | (u32)(127 - (lr * 8 + 6)); k[7] = (ord_key(s1.w) & ~0x7fu) | (u32)(127 - (lr * 8 + 7));
            CEX(0, 1) CEX(2, 3) CEX(4, 5) CEX(6, 7)  CEX(0, 2) CEX(1, 3) CEX(4, 6) CEX(5, 7)  CEX(1, 2) CEX(5, 6) CEX(0, 4) CEX(3, 7)
            CEX(1, 5) CEX(2, 6)  CEX(1, 4) CEX(3, 6)  CEX(2, 4) CEX(3, 5)  CEX(3, 4)
            u32 sel = 0u;
#pragma unroll
            for (int r = 0; r < 16; ++r) {
                const u32 bm = row_allmax(k[0]);
                if (k[0] == bm) { k[0] = k[1]; k[1] = k[2]; k[2] = k[3]; k[3] = k[4]; k[4] = k[5]; k[5] = k[6]; k[6] = k[7]; k[7] = 0u; }
                if (lr == r) sel = bm;
            }
            TOPV[(t * 2 + z) * 16 + lr] = ord_val(sel & ~0x7fu); TOPI[(t * 2 + z) * 16 + lr] = 127 - (int)(sel & 0x7fu);
        }
        __syncthreads();
        for (int rd = 0; rd < 2; ++rd) {
            const int t = rd * 32 + wave * 4 + lq;
            const float* tv = TOPV + t * 32; const int* ti = TOPI + t * 32;
            u32 k[4];
#pragma unroll
            for (int q = 0; q < 4; ++q) k[q] = (ord_key(tv[ca[q]] + tv[16 + cb[q]]) & ~0xffu) | (u32)(255 - (ca[q] * 16 + cb[q]));
            if (!c3ok) k[3] = 0u;
            u32 sel = 0u;
#pragma unroll
            for (int r = 0; r < 16; ++r) {
                const u32 bm = row_allmax(umax(umax(k[0], k[1]), umax(k[2], k[3])));
#pragma unroll
                for (int q = 0; q < 4; ++q) if (k[q] == bm) k[q] = 0u;
                if (lr == r) sel = bm;
            }
            const int cj = 255 - (int)(sel & 0xffu); const int ia = ti[(cj >> 4) & 15], ib = ti[16 + (cj & 15)];
            const float bv = ord_val(sel & ~0xffu); const float top = ord_val(row_allmax(sel) & ~0xffu);
            const float ex = __expf(bv - top);
            float sm = ex;
            sm += __uint_as_float(row_ror<8>(__float_as_uint(sm))); sm += __uint_as_float(row_ror<4>(__float_as_uint(sm)));
            sm += __uint_as_float(row_ror<2>(__float_as_uint(sm))); sm += __uint_as_float(row_ror<1>(__float_as_uint(sm)));
            EIDX[(size_t)(m0 + t) * 128 + head * 16 + lr] = ia * 128 + ib; EG[(size_t)(m0 + t) * 128 + head * 16 + lr] = ex / sm;
        }
        __syncthreads();
    }
}
#undef CEX

__device__ __forceinline__ float ub(u32 w, int k) { return (float)((w >> (8 * k)) & 0xffu); }
typedef float f32x2_t __attribute__((ext_vector_type(2)));
__device__ __forceinline__ float row_allsum_f(float v) {
    v += __uint_as_float(row_ror<8>(__float_as_uint(v))); v += __uint_as_float(row_ror<4>(__float_as_uint(v)));
    v += __uint_as_float(row_ror<2>(__float_as_uint(v))); v += __uint_as_float(row_ror<1>(__float_as_uint(v))); return v; }
__device__ __forceinline__ float gelu_fast(float x) { return x * frcp(1.f + __expf(-1.5957691216057308f * (x + 0.044715f * x * x * x))); }
__device__ __forceinline__ void ph_experts(const Params& p, int l, int nrows, const float* x_lat, const float* x_ctx, float* o_lat, float* o_ctx, unsigned char* smem, bool fuse_norm, int abl = 0) {
    const unsigned char* HQ = p.ws + OFF_HQ; const float* HQS = (const float*)(p.ws + OFF_HQS); const int* EIDX = (const int*)(p.ws + OFF_EIDX); const float* EG = (const float*)(p.ws + OFF_EG);
    const unsigned char* TU = p.ws + (l == 0 ? OFF_TU0 : OFF_TU1); const unsigned char* TV = p.ws + (l == 0 ? OFF_TV0 : OFF_TV1);
    const bf16_t* TUS = (const bf16_t*)(TU + 32 * MiB); const bf16_t* TVS = (const bf16_t*)(TV + 32 * MiB);
    const float* modv = (const float*)(p.ws + OFF_MODV);
    float* part = (float*)smem;
    const int tid = TID(), lane = tid & 63, wave = __builtin_amdgcn_readfirstlane(tid >> 6);
    const int bid = blockIdx.x, G = gridDim.x;
    const int ntok = bid < nrows ? (nrows - bid + G - 1) / G : 0; const int NGp = ntok * 4;
    u32x4 uq[3][4], vq[3][4]; u32 su[3][4], sv[3][4]; float gw[3][4];
    u32x4 nidx = {0u, 0u, 0u, 0u}; f32x4 ngw = {0.f, 0.f, 0.f, 0.f};
    u32x4 hnext[2]; float hsnext = 0.f;
    int hqe[4], hqo[4]; float hscale = 0.f;
    f32x2_t acc[16]; float wtot = 0.f;
    float kfp8; { int one_ = 1; asm volatile("" : "+v"(one_)); kfp8 = 1.f / __builtin_amdgcn_cvt_pk_f32_fp8(one_, false)[0]; }
#pragma unroll
    for (int e = 0; e < 16; ++e) acc[e] = (f32x2_t){0.f, 0.f};
    const unsigned short* TUS16 = (const unsigned short*)TUS; const unsigned short* TVS16 = (const unsigned short*)TVS;
#define LOADIDX(gidx) do { const int g_ = min((int)(gidx), NGp - 1); const int m_ = bid + (g_ >> 2) * G; \
        nidx = *(const u32x4*)(EIDX + (size_t)m_ * 128 + wave * 16 + (g_ & 3) * 4); ngw = *(const f32x4*)(EG + (size_t)m_ * 128 + wave * 16 + (g_ & 3) * 4); } while (0)
#define ISSUE(B, NEXTG) do { int es_[4]; \
        _Pragma("unroll") for (int i = 0; i < 4; ++i) { es_[i] = __builtin_amdgcn_readfirstlane((int)nidx[i]); gw[B][i] = __int_as_float(__builtin_amdgcn_readfirstlane(__float_as_int(ngw[i]))); } \
        LOADIDX(NEXTG); \
        _Pragma("unroll") for (int i = 0; i < 4; ++i) { const int e_ = es_[i]; \
            su[B][i] = TUS16[(size_t)e_ * 64 + lane]; sv[B][i] = TVS16[(size_t)e_ * 64 + lane]; uq[B][i] = *(const u32x4*)(TU + (size_t)e_ * 1024 + lane * 16); vq[B][i] = *(const u32x4*)(TV + (size_t)e_ * 1024 + lane * 16); } } while (0)
#define LOADH(t_) do { const int m_ = bid + min((int)(t_), ntok - 1) * G; hnext[0] = *(const u32x4*)(HQ + (size_t)m_ * DM + lane * 32); hnext[1] = *(const u32x4*)(HQ + (size_t)m_ * DM + lane * 32 + 16); hsnext = HQS[m_]; } while (0)
#define BODY(B, gidx) do { \
        if (((gidx) & 3) == 0) {   \
            asm volatile("v_mov_b32 %0, %1" : "=v"(hscale) : "v"(hsnext)); \
            _Pragma("unroll") for (int d = 0; d < 4; ++d) { asm volatile("v_mov_b32 %0, %1" : "=v"(hqe[d]) : "v"(hnext[0][d])); asm volatile("v_mov_b32 %0, %1" : "=v"(hqo[d]) : "v"(hnext[1][d])); }     \
            _Pragma("unroll") for (int e = 0; e < 16; ++e) acc[e] = (f32x2_t){0.f, 0.f}; wtot = 0.f; \
            __builtin_amdgcn_sched_barrier(0); \
            LOADH(((gidx) >> 2) + 1); \
            { const int m_ = bid + min((int)((gidx) >> 2), ntok - 1) * G; xpre = __builtin_nontemporal_load((const f32x4*)((m_ >= NL ? x_ctx + (size_t)(m_ - NL) * DM : x_lat + (size_t)m_ * DM) + tid * 4)); } } \
        ISSUE(((B) + 2) % 3, (gidx) + 3);     \
        if (abl == 2) { _Pragma("unroll") for (int i = 0; i < 4; ++i) { const u32x4 t_ = uq[B][i] ^ vq[B][i]; acc[i][0] += __uint_as_float((t_.x ^ t_.y ^ t_.z ^ t_.w) & 0x3fffffu) * __uint_as_float(su[B][i] << 16) * __uint_as_float(sv[B][i] << 16); } } \
        else { \
        float zl[4]; \
        _Pragma("unroll") for (int i = 0; i < 4; ++i) { int d_ = 0; \
            _Pragma("unroll") for (int d = 0; d < 4; ++d) d_ = __builtin_amdgcn_sdot8((int)uq[B][i][d], hqe[d], d_, false); \
            d_ <<= 4; \
            _Pragma("unroll") for (int d = 0; d < 4; ++d) d_ = __builtin_amdgcn_sdot8((int)uq[B][i][d], hqo[d], d_, false); \
            const float zz_ = row_allsum_f(__uint_as_float(su[B][i] << 16) * (float)d_); \
            zl[i] = __int_as_float(__builtin_amdgcn_readlane(__float_as_int(zz_), 0)) + __int_as_float(__builtin_amdgcn_readlane(__float_as_int(zz_), 16)) \
                    + __int_as_float(__builtin_amdgcn_readlane(__float_as_int(zz_), 32)) + __int_as_float(__builtin_amdgcn_readlane(__float_as_int(zz_), 48)); } \
        _Pragma("unroll") for (int i = 0; i < 4; ++i) { \
            const float w = gw[B][i] * gelu_fast(zl[i] * hscale) * __uint_as_float(sv[B][i] << 16); wtot += w; const float wk = w * kfp8; const f32x2_t w2 = {wk, wk}; \
            _Pragma("unroll") for (int d = 0; d < 4; ++d) { u32 lo = vq[B][i][d] & 0x0f0f0f0fu, hi = (vq[B][i][d] >> 4) & 0x0f0f0f0fu; asm volatile("" : "+v"(lo), "+v"(hi)); \
                  \
                acc[d * 4 + 0] += w2 * __builtin_amdgcn_cvt_pk_f32_fp8((int)lo, false); acc[d * 4 + 1] += w2 * __builtin_amdgcn_cvt_pk_f32_fp8((int)hi, false); \
                acc[d * 4 + 2] += w2 * __builtin_amdgcn_cvt_pk_f32_fp8((int)lo, true);  acc[d * 4 + 3] += w2 * __builtin_amdgcn_cvt_pk_f32_fp8((int)hi, true); } } \
        } \
        if (((gidx) & 3) == 3) {   \
            const int m = bid + ((gidx) >> 2) * G; const float wt8 = wtot * 8.f; \
            { float* d = part + wave * 2048 + lane * 4; \
              _Pragma("unroll") for (int q = 0; q < 8; ++q) *(f32x4*)(d + q * 256) = (f32x4){acc[q * 2][0] - wt8, acc[q * 2 + 1][0] - wt8, acc[q * 2][1] - wt8, acc[q * 2 + 1][1] - wt8}; } \
            __syncthreads(); \
            f32x4 xv; const bool isc = m >= NL; const float* cv = cst + (isc ? 3 * 2048 : 0) + tid * 4; \
            { f32x4 sm = {0.f, 0.f, 0.f, 0.f}; \
              _Pragma("unroll") for (int w_ = 0; w_ < 8; ++w_) sm += *(const f32x4*)(part + w_ * 2048 + tid * 4); \
              float* orow = isc ? o_ctx + (size_t)(m - NL) * DM : o_lat + (size_t)m * DM; \
              const f32x4 gate = *(const f32x4*)cv; \
              xv = xpre + gate * sm; __builtin_nontemporal_store(xv, (f32x4*)(orow + tid * 4)); } \
            if (fuse_norm) {   \
                const f32x4 gs = *(const f32x4*)(cv + 2048), sh = *(const f32x4*)(cv + 4096); \
                const f32x4 xg = xv * gs; \
                float ss = xv.x * xv.x + xv.y * xv.y + xv.z * xv.z + xv.w * xv.w; ss = wave_sum(ss); \
                const float m1 = wave_max(fmaxf(fmaxf(fabsf(xg.x), fabsf(xg.y)), fmaxf(fabsf(xg.z), fabsf(xg.w)))); \
                if (lane == 0) { red[wave] = ss; red[8 + wave] = m1; } \
                __syncthreads(); \
                const float tot = ((red[0] + red[1]) + (red[2] + red[3])) + ((red[4] + red[5]) + (red[6] + red[7])); \
                const float M1 = fmaxf(fmaxf(fmaxf(red[8], red[9]), fmaxf(red[10], red[11])), fmaxf(fmaxf(red[12], red[13]), fmaxf(red[14], red[15]))); \
                const float M2 = red[32 + (isc ? 1 : 0)]; \
                const float r = rsqrtf(tot * (1.f / 2048.f) + 1e-6f); \
                const float bnd = fmaxf(r * M1 + M2, 1e-30f); const float inv8 = 127.f / bnd; \
                const f32x4 y = xg * r + sh; \
                const u32 q8 = ((u32)((int)rintf(y.x * inv8)) & 0xffu) | (((u32)((int)rintf(y.y * inv8)) & 0xffu) << 8) | (((u32)((int)rintf(y.z * inv8)) & 0xffu) << 16) | (((u32)((int)rintf(y.w * inv8)) & 0xffu) << 24); \
                *(u32*)(p.ws + OFF_H8 + (size_t)m * DM + tid * 4) = q8; \
                if (tid == 0) ((float*)(p.ws + OFF_HS8))[m] = bnd * (1.f / 127.f); \
                __syncthreads(); \
            } else __syncthreads(); } \
    } while (0)
    float* red = (float*)(smem + 65536); float* cst = (float*)(smem + 66 * 1024); f32x4 xpre = {0.f, 0.f, 0.f, 0.f};
    __syncthreads();
#pragma unroll
    for (int v_ = 0; v_ < 2; ++v_) {
        *(f32x4*)(cst + v_ * 3 * 2048 + tid * 4) = *(const f32x4*)(modv + (size_t)(l * 2 + v_) * 12288 + 5 * 2048 + tid * 4);
        float m2 = 0.f;
        if (fuse_norm) { const float* mv = modv + (size_t)((l + 1) * 2 + v_) * 12288;
            const f32x4 gg = *(const f32x4*)(p.norm_g + (size_t)((l + 1) * 2) * 2048 + tid * 4), sh = *(const f32x4*)(mv + tid * 4), sc = *(const f32x4*)(mv + 2048 + tid * 4);
            *(f32x4*)(cst + (v_ * 3 + 1) * 2048 + tid * 4) = gg * (sc + 1.f); *(f32x4*)(cst + (v_ * 3 + 2) * 2048 + tid * 4) = sh;
            m2 = wave_max(fmaxf(fmaxf(fabsf(sh.x), fabsf(sh.y)), fmaxf(fabsf(sh.z), fabsf(sh.w)))); }
        if (lane == 0) red[16 + v_ * 8 + wave] = m2;
    }
    __syncthreads();
    if (tid < 2) red[32 + tid] = fmaxf(fmaxf(fmaxf(red[16 + tid * 8], red[17 + tid * 8]), fmaxf(red[18 + tid * 8], red[19 + tid * 8])), fmaxf(fmaxf(red[20 + tid * 8], red[21 + tid * 8]), fmaxf(red[22 + tid * 8], red[23 + tid * 8])));
    __syncthreads();
    if (ntok > 0) { LOADH(0); LOADIDX(0); ISSUE(0, 1); ISSUE(1, 2); }
    for (int gi = 0; gi < NGp; gi += 3) {
        BODY(0, gi);
        BODY(1, gi + 1);
        BODY(2, gi + 2);
    }
#undef LOADIDX
#undef ISSUE
#undef LOADH
#undef BODY
}

__device__ __forceinline__ void ph_experts_w(const Params& p, int l, int nrows, const float* x_lat, float* o_lat, unsigned char* smem, bool fuse_norm) {
    const unsigned char* HQ = p.ws + OFF_HQ; const float* HQS = (const float*)(p.ws + OFF_HQS); const int* EIDX = (const int*)(p.ws + OFF_EIDX); const float* EG = (const float*)(p.ws + OFF_EG);
    const unsigned char* TU = p.ws + (l == 0 ? OFF_TU0 : OFF_TU1); const unsigned char* TV = p.ws + (l == 0 ? OFF_TV0 : OFF_TV1);
    const unsigned short* TUS16 = (const unsigned short*)(TU + 32 * MiB); const unsigned short* TVS16 = (const unsigned short*)(TV + 32 * MiB);
    const float* modv = (const float*)(p.ws + OFF_MODV);
    const int tid = TID(), lane = tid & 63, wave = __builtin_amdgcn_readfirstlane(tid >> 6);
    const int wg = blockIdx.x * 8 + wave, NW = gridDim.x * 8;
    const int ntok = wg < nrows ? (nrows - wg + NW - 1) / NW : 0; const int NGp = ntok * 32;
    float* red = (float*)(smem + 65536); float* cst = (float*)(smem + 66 * 1024);
    __syncthreads();
    {   *(f32x4*)(cst + tid * 4) = *(const f32x4*)(modv + (size_t)(l * 2) * 12288 + 5 * 2048 + tid * 4);
        float m2 = 0.f;
        if (fuse_norm) { const float* mv = modv + (size_t)((l + 1) * 2) * 12288;
            const f32x4 gg = *(const f32x4*)(p.norm_g + (size_t)((l + 1) * 2) * 2048 + tid * 4), sh = *(const f32x4*)(mv + tid * 4), sc = *(const f32x4*)(mv + 2048 + tid * 4);
            *(f32x4*)(cst + 2048 + tid * 4) = gg * (sc + 1.f); *(f32x4*)(cst + 4096 + tid * 4) = sh;
            m2 = wave_max(fmaxf(fmaxf(fabsf(sh.x), fabsf(sh.y)), fmaxf(fabsf(sh.z), fabsf(sh.w)))); }
        if (lane == 0) red[16 + wave] = m2; }
    __syncthreads();
    const float M2 = fmaxf(fmaxf(fmaxf(red[16], red[17]), fmaxf(red[18], red[19])), fmaxf(fmaxf(red[20], red[21]), fmaxf(red[22], red[23])));
    u32x4 uq[3][4], vq[3][4]; u32 su[3][4], sv[3][4]; float gw[3][4];
    u32x4 nidx = {0u, 0u, 0u, 0u}; f32x4 ngw = {0.f, 0.f, 0.f, 0.f};
    u32x4 hnext[2]; float hsnext = 0.f;
    int hqe[4], hqo[4]; float hscale = 0.f;
    f32x2_t acc[16]; float wtot = 0.f;
    float kfp8; { int one_ = 1; asm volatile("" : "+v"(one_)); kfp8 = 1.f / __builtin_amdgcn_cvt_pk_f32_fp8(one_, false)[0]; }
#pragma unroll
    for (int e = 0; e < 16; ++e) acc[e] = (f32x2_t){0.f, 0.f};
#define LOADIDX(gidx) do { const int g_ = min((int)(gidx), NGp - 1); const int m_ = wg + (g_ >> 5) * NW; \
        nidx = *(const u32x4*)(EIDX + (size_t)m_ * 128 + (g_ & 31) * 4); ngw = *(const f32x4*)(EG + (size_t)m_ * 128 + (g_ & 31) * 4); } while (0)
#define ISSUE(B, NEXTG) do { int es_[4]; \
        _Pragma("unroll") for (int i = 0; i < 4; ++i) { es_[i] = __builtin_amdgcn_readfirstlane((int)nidx[i]); gw[B][i] = __int_as_float(__builtin_amdgcn_readfirstlane(__float_as_int(ngw[i]))); } \
        LOADIDX(NEXTG); \
        _Pragma("unroll") for (int i = 0; i < 4; ++i) { const int e_ = es_[i]; \
            su[B][i] = TUS16[(size_t)e_ * 64 + lane]; sv[B][i] = TVS16[(size_t)e_ * 64 + lane]; uq[B][i] = *(const u32x4*)(TU + (size_t)e_ * 1024 + lane * 16); vq[B][i] = *(const u32x4*)(TV + (size_t)e_ * 1024 + lane * 16); } } while (0)
#define LOADH(t_) do { const int m_ = wg + min((int)(t_), ntok - 1) * NW; hnext[0] = *(const u32x4*)(HQ + (size_t)m_ * DM + lane * 32); hnext[1] = *(const u32x4*)(HQ + (size_t)m_ * DM + lane * 32 + 16); hsnext = HQS[m_]; } while (0)
#define BODY(B, gidx) do { \
        if (((gidx) & 31) == 0) { \
            asm volatile("v_mov_b32 %0, %1" : "=v"(hscale) : "v"(hsnext)); \
            _Pragma("unroll") for (int d = 0; d < 4; ++d) { asm volatile("v_mov_b32 %0, %1" : "=v"(hqe[d]) : "v"(hnext[0][d])); asm volatile("v_mov_b32 %0, %1" : "=v"(hqo[d]) : "v"(hnext[1][d])); } \
            _Pragma("unroll") for (int e = 0; e < 16; ++e) acc[e] = (f32x2_t){0.f, 0.f}; wtot = 0.f; \
            __builtin_amdgcn_sched_barrier(0); \
            LOADH(((gidx) >> 5) + 1); } \
        ISSUE(((B) + 2) % 3, (gidx) + 3); \
        float zl[4]; \
        _Pragma("unroll") for (int i = 0; i < 4; ++i) { int d_ = 0; \
            _Pragma("unroll") for (int d = 0; d < 4; ++d) d_ = __builtin_amdgcn_sdot8((int)uq[B][i][d], hqe[d], d_, false); \
            d_ <<= 4; \
            _Pragma("unroll") for (int d = 0; d < 4; ++d) d_ = __builtin_amdgcn_sdot8((int)uq[B][i][d], hqo[d], d_, false); \
            const float zz_ = row_allsum_f(__uint_as_float(su[B][i] << 16) * (float)d_); \
            zl[i] = __int_as_float(__builtin_amdgcn_readlane(__float_as_int(zz_), 0)) + __int_as_float(__builtin_amdgcn_readlane(__float_as_int(zz_), 16)) \
                    + __int_as_float(__builtin_amdgcn_readlane(__float_as_int(zz_), 32)) + __int_as_float(__builtin_amdgcn_readlane(__float_as_int(zz_), 48)); } \
        _Pragma("unroll") for (int i = 0; i < 4; ++i) { \
            const float w = gw[B][i] * gelu_fast(zl[i] * hscale) * __uint_as_float(sv[B][i] << 16); wtot += w; const float wk = w * kfp8; const f32x2_t w2 = {wk, wk}; \
            _Pragma("unroll") for (int d = 0; d < 4; ++d) { u32 lo = vq[B][i][d] & 0x0f0f0f0fu, hi = (vq[B][i][d] >> 4) & 0x0f0f0f0fu; asm volatile("" : "+v"(lo), "+v"(hi)); \
                acc[d * 4 + 0] += w2 * __builtin_amdgcn_cvt_pk_f32_fp8((int)lo, false); acc[d * 4 + 1] += w2 * __builtin_amdgcn_cvt_pk_f32_fp8((int)hi, false); \
                acc[d * 4 + 2] += w2 * __builtin_amdgcn_cvt_pk_f32_fp8((int)lo, true);  acc[d * 4 + 3] += w2 * __builtin_amdgcn_cvt_pk_f32_fp8((int)hi, true); } } \
        if (((gidx) & 31) == 31 && ((gidx) >> 5) < ntok) {   \
            const int m = wg + ((gidx) >> 5) * NW; const float wt8 = wtot * 8.f; \
            const float* xr = x_lat + (size_t)m * DM + lane * 4; float* orow = o_lat + (size_t)m * DM + lane * 4; \
            f32x4 xv[8]; float ss = 0.f, m1 = 0.f; \
            _Pragma("unroll") for (int q = 0; q < 8; ++q) xv[q] = __builtin_nontemporal_load((const f32x4*)(xr + q * 256)); \
            _Pragma("unroll") for (int q = 0; q < 8; ++q) { \
                const f32x4 sm = {acc[q * 2][0] - wt8, acc[q * 2 + 1][0] - wt8, acc[q * 2][1] - wt8, acc[q * 2 + 1][1] - wt8}; \
                const f32x4 gate = *(const f32x4*)(cst + q * 256 + lane * 4); \
                xv[q] += gate * sm; __builtin_nontemporal_store(xv[q], (f32x4*)(orow + q * 256)); \
                if (fuse_norm) { const f32x4 xg = xv[q] * *(const f32x4*)(cst + 2048 + q * 256 + lane * 4); \
                    ss += xv[q].x * xv[q].x + xv[q].y * xv[q].y + xv[q].z * xv[q].z + xv[q].w * xv[q].w; m1 = fmaxf(m1, fmaxf(fmaxf(fabsf(xg.x), fabsf(xg.y)), fmaxf(fabsf(xg.z), fabsf(xg.w)))); } } \
            if (fuse_norm) { \
                ss = wave_sum(ss); m1 = wave_max(m1); \
                const float r = rsqrtf(ss * (1.f / 2048.f) + 1e-6f); \
                const float bnd = fmaxf(r * m1 + M2, 1e-30f); const float inv8 = 127.f / bnd; \
                _Pragma("unroll") for (int q = 0; q < 8; ++q) { \
                    const f32x4 y = xv[q] * *(const f32x4*)(cst + 2048 + q * 256 + lane * 4) * r + *(const f32x4*)(cst + 4096 + q * 256 + lane * 4); \
                    const u32 q8 = ((u32)((int)rintf(y.x * inv8)) & 0xffu) | (((u32)((int)rintf(y.y * inv8)) & 0xffu) << 8) | (((u32)((int)rintf(y.z * inv8)) & 0xffu) << 16) | (((u32)((int)rintf(y.w * inv8)) & 0xffu) << 24); \
                    *(u32*)(p.ws + OFF_H8 + (size_t)m * DM + q * 256 + lane * 4) = q8; } \
                if (lane == 0) ((float*)(p.ws + OFF_HS8))[m] = bnd * (1.f / 127.f); } } \
    } while (0)
    if (ntok > 0) { LOADH(0); LOADIDX(0); ISSUE(0, 1); ISSUE(1, 2); }
    for (int gi = 0; gi < NGp; gi += 3) {
        BODY(0, gi);
        BODY(1, gi + 1);
        BODY(2, gi + 2);
    }
#undef LOADIDX
#undef ISSUE
#undef LOADH
#undef BODY
}

__device__ __forceinline__ void ph_prep_cd(const Params& p, unsigned char* smem) {
    const bf16_t* PCD = (const bf16_t*)(p.ws + OFF_PAB);
    bf16_t* CQ = (bf16_t*)(p.ws + OFF_CQ); bf16_t* CK = (bf16_t*)(p.ws + OFF_CK); bf16_t* DQ = (bf16_t*)(p.ws + OFF_DQ); bf16_t* DK = (bf16_t*)(p.ws + OFF_DK);
    {
        bf16_t* CVT = (bf16_t*)(p.ws + OFF_CVT); bf16_t* DVT = (bf16_t*)(p.ws + OFF_DVT);
        bf16_t* tV = (bf16_t*)smem; const int tid = TID();
        for (int u = blockIdx.x; u < 132 * 10; u += gridDim.x) {
            const int tt = u / 10, vh = u % 10; const int m0 = tt * 64; const int col = vh < 8 ? 1024 + vh * 128 : 2304 + (vh - 8) * 128;
            bf16_t* dst = vh < 8 ? CVT + (size_t)vh * 128 * NT : DVT + (size_t)(vh - 8) * 128 * NT;
            for (int e = tid; e < 64 * 16; e += NTHR) { const int tau = e >> 4, c8 = e & 15; *(u32x4*)(tV + tau * 128 + c8 * 8) = *(const u32x4*)(PCD + (size_t)(m0 + tau) * PCD_LD + col + c8 * 8); }
            __syncthreads();
            for (int e = tid; e < 128 * 8; e += NTHR) { const int d = e >> 3, c8 = e & 7; u32 tv[8];
#pragma unroll
                for (int j = 0; j < 8; ++j) tv[j] = tV[(c8 * 8 + j) * 128 + d];
                u32x4 ov; ov.x = tv[0] | (tv[1] << 16); ov.y = tv[2] | (tv[3] << 16); ov.z = tv[4] | (tv[5] << 16); ov.w = tv[6] | (tv[7] << 16);
                *(u32x4*)(dst + (size_t)d * NT + m0 + c8 * 8) = ov; }
            __syncthreads();
        }
    }
    const int lane = TID() & 63, wave = TID() >> 6, lr = lane & 15, lq = lane >> 4;
    const int i0 = 4 * (lr & 7) + 64 * (lr >> 3);
    float fr[4];
#pragma unroll
    for (int e = 0; e < 4; ++e) fr[e] = __powf(10000.f, -(float)(4 * (lr & 7) + e) * (1.f / 32.f));
    for (int jw = blockIdx.x * 8 + wave; jw < NT * 26 / 4; jw += gridDim.x * 8) {
        const int j = jw * 4 + lq; const int m = j / 26, s_ = j % 26;
        const bool skip = m >= NL && (s_ < 8 || (s_ >= 16 && s_ < 24));
        int col, gi; bool rope; float scale; bf16_t* dst;
        if (s_ < 8) { col = 2560 + s_ * 128; gi = 0; rope = false; scale = 0.08838834764831845f * 1.4426950408889634f; dst = CQ + ((size_t)s_ * NL + m) * 128; }
        else if (s_ < 16) { col = (s_ - 8) * 128; gi = 1; rope = false; scale = 1.f; dst = CK + ((size_t)(s_ - 8) * NT + m) * 128; }
        else if (s_ < 24) { col = 3584 + (s_ - 16) * 128; gi = 2; rope = true; scale = 0.08838834764831845f * 1.4426950408889634f; dst = DQ + ((size_t)(s_ - 16) * NL + m) * 128; }
        else { col = 2048 + (s_ - 24) * 128; gi = 3; rope = m < NL; scale = 1.f; dst = DK + ((size_t)(s_ - 24) * NT + m) * 128; }
        const bf16_t* src = PCD + (size_t)m * PCD_LD + col;
        const u32x2 lo2 = *(const u32x2*)(src + i0), hi2 = *(const u32x2*)(src + i0 + 32);
        float x[4] = {bfl(lo2.x), bfh(lo2.x), bfl(lo2.y), bfh(lo2.y)}, y[4] = {bfl(hi2.x), bfh(hi2.x), bfl(hi2.y), bfh(hi2.y)};
        float ss = x[0] * x[0] + x[1] * x[1] + x[2] * x[2] + x[3] * x[3] + y[0] * y[0] + y[1] * y[1] + y[2] * y[2] + y[3] * y[3];
        ss += __shfl_xor(ss, 1); ss += __shfl_xor(ss, 2); ss += __shfl_xor(ss, 4); ss += __shfl_xor(ss, 8);
        const float r = rsqrtf(ss * (1.f / 128.f) + 1e-6f);
        const f32x4 g0 = *(const f32x4*)(p.cd_qk_g + gi * 128 + i0), g1 = *(const f32x4*)(p.cd_qk_g + gi * 128 + i0 + 32);
        const float pos = (float)((lr < 8) ? (m >> 6) : (m & 63));
#pragma unroll
        for (int e = 0; e < 4; ++e) { float a = x[e] * r * g0[e], b = y[e] * r * g1[e];
            if (rope) { const float ang = pos * fr[e]; const float cs = __cosf(ang), sn = __sinf(ang);     const float a2 = a * cs - b * sn, b2 = a * sn + b * cs; a = a2; b = b2; }
            x[e] = a * scale; y[e] = b * scale; }
        if (!skip) { u32x2 o0, o1; o0.x = pk2(x[0], x[1]); o0.y = pk2(x[2], x[3]); o1.x = pk2(y[0], y[1]); o1.y = pk2(y[2], y[3]);
            *(u32x2*)(dst + i0) = o0; *(u32x2*)(dst + i0 + 32) = o1; }
    }
}

__device__ __forceinline__ void ph_attn(const Params& p, unsigned char* smem) {
    const bf16_t* CQ = (const bf16_t*)(p.ws + OFF_CQ); const bf16_t* CK = (const bf16_t*)(p.ws + OFF_CK); const bf16_t* DQ = (const bf16_t*)(p.ws + OFF_DQ); const bf16_t* DK = (const bf16_t*)(p.ws + OFF_DK);
    const bf16_t* CVT = (const bf16_t*)(p.ws + OFF_CVT); const bf16_t* DVT = (const bf16_t*)(p.ws + OFF_DVT);
    bf16_t* YM = (bf16_t*)(p.ws + OFF_YM);
    const int tid = TID(), lane = tid & 63, wave = tid >> 6, lr = lane & 15, lq = lane >> 4, mt = wave & 3, hl = wave >> 2;
    constexpr int KT_B = 64 * 272, VT_B = 128 * 144, SLOT_B = KT_B + VT_B;
    constexpr int BUF_B = 2 * SLOT_B;
    bf16_t* Pt = (bf16_t*)(smem + 2 * BUF_B) + wave * (16 * 64);
    float* rp = (float*)(smem + 2 * BUF_B + 16384);
    for (int u = blockIdx.x; u < 1024; u += gridDim.x) {
        const int kind = unit_kind(u), r = u >> 1, hp = r & 3, qt = r >> 2; const int h = hp * 2 + hl;
        const int q0 = qt * 64 + mt * 16;
        const bf16_t* Qb = kind == 0 ? CQ + ((size_t)h * NL + q0) * 128 : DQ + ((size_t)h * NL + q0) * 128;
        const bf16_t* Ks0 = kind == 0 ? CK + (size_t)(hp * 2) * NT * 128 : DK + (size_t)(hp >> 1) * NT * 128;
        const bf16_t* Vs0 = kind == 0 ? CVT + (size_t)(hp * 2) * 128 * NT : DVT + (size_t)(hp >> 1) * 128 * NT;
        const int npc = kind == 0 ? 8 : 4;
        const int slot = kind == 0 ? hl : 0;
        bf16x8_t qa[4];
#pragma unroll
        for (int ks = 0; ks < 4; ++ks) qa[ks] = ld8(Qb + (size_t)lr * 128 + ks * 32 + 8 * lq);
        f32x4 o[8];
#pragma unroll
        for (int i = 0; i < 8; ++i) o[i] = (f32x4){0.f, 0.f, 0.f, 0.f};
        float mrow = -1e30f, lrow = 0.f;
        const int cq = mt * 16 + lr;
        const int lo1 = min(max(cq - 8, 0), 48) - cq;
        const int rs = min(max(qt - 4, 0), 120);
        const int nloc = kind == 0 ? 8 : 5;
        int bfirst = 0, blast = kind == 0 ? 11 : 8;
        if (kind == 1) { if (qt < 2) bfirst = 2 - qt; }
#define KEY0(b) ((b) < nloc ? (kind == 0 ? (rs + (b)) * 64 : (qt - 2 + (b)) * 64) : NL + ((b) - nloc) * 64)
#define BVALID(b) (!(kind == 1 && (b) < nloc && (qt - 2 + (b)) > 127))
        u32x4 st[8];
#define PREFETCH(b) do { const int k0_ = KEY0(b); _Pragma("unroll") for (int i = 0; i < 8; ++i) if (i < npc) { \
            const int pc = tid + NTHR * (i & 1); \
            if (kind == 0) { const int sl = (i >> 1) & 1; if (i < 4) st[i] = *(const u32x4*)(Ks0 + (size_t)sl * NT * 128 + (size_t)(k0_ + (pc >> 4)) * 128 + (pc & 15) * 8); \
                             else st[i] = *(const u32x4*)(Vs0 + (size_t)sl * 128 * NT + (size_t)(pc >> 3) * NT + k0_ + (pc & 7) * 8); } \
            else { if (i < 2) st[i] = *(const u32x4*)(Ks0 + (size_t)(k0_ + (pc >> 4)) * 128 + (pc & 15) * 8); else st[i] = *(const u32x4*)(Vs0 + (size_t)(pc >> 3) * NT + k0_ + (pc & 7) * 8); } } } while (0)
#define STAGEW(bufo) do { unsigned char* sb_ = smem + (bufo); _Pragma("unroll") for (int i = 0; i < 8; ++i) if (i < npc) { const int pc = tid + NTHR * (i & 1); \
            if (kind == 0) { const int sl = (i >> 1) & 1; if (i < 4) *(u32x4*)(sb_ + sl * SLOT_B + (pc >> 4) * 272 + (pc & 15) * 16) = st[i]; else *(u32x4*)(sb_ + sl * SLOT_B + KT_B + (pc >> 3) * 144 + (pc & 7) * 16) = st[i]; } \
            else { if (i < 2) *(u32x4*)(sb_ + (pc >> 4) * 272 + (pc & 15) * 16) = st[i]; else *(u32x4*)(sb_ + KT_B + (pc >> 3) * 144 + (pc & 7) * 16) = st[i]; } } } while (0)
        PREFETCH(bfirst);
        const float rpv0 = p.cd_rpb[(size_t)hp * 930 + min(tid, 929)], rpv1 = p.cd_rpb[(size_t)hp * 930 + min(tid + NTHR, 929)];
        const float sinkv = p.cd_sink[h];
        __syncthreads();
        if (kind == 0) { rp[tid] = rpv0 * 1.4426950408889634f; if (tid + NTHR < 930) rp[tid + NTHR] = rpv1 * 1.4426950408889634f; }
        STAGEW(0);
        __syncthreads();
        { int bn = bfirst + 1; while (bn <= blast && !BVALID(bn)) ++bn; if (bn <= blast) PREFETCH(bn); }
        int cnt = 0;
        for (int b = bfirst; b <= blast; ++b) {
            if (!BVALID(b)) continue;
            const unsigned char* Kl = smem + (cnt & 1) * BUF_B + slot * SLOT_B; const unsigned char* Vl = Kl + KT_B;
            const bool loc = b < nloc; const int key0 = KEY0(b);
#define ATT_TAIL(NT_, kb_) do { \
            float m = sv[0][0]; \
            _Pragma("unroll") for (int t = 0; t < NT_; ++t) _Pragma("unroll") for (int rg = 0; rg < 4; ++rg) m = fmaxf(m, sv[t][rg]); \
            m = fmaxf(m, __shfl_xor(m, 16)); m = fmaxf(m, __shfl_xor(m, 32)); \
            float mx = fmaxf(m, mrow); \
            if (__any(mx > mrow + 8.f)) {     \
                const float corr = __builtin_amdgcn_exp2f(mrow - mx); mrow = mx; lrow *= corr; \
                _Pragma("unroll") for (int i = 0; i < 8; ++i) o[i] *= corr; \
            } else mx = mrow; \
            u32 pb[NT_][2]; \
            _Pragma("unroll") for (int t = 0; t < NT_; ++t) { float pv[4]; \
                _Pragma("unroll") for (int rg = 0; rg < 4; ++rg) { pv[rg] = __builtin_amdgcn_exp2f(sv[t][rg] - mx); lrow += pv[rg]; } \
                pb[t][0] = pk2(pv[0], pv[1]); pb[t][1] = pk2(pv[2], pv[3]); } \
            _Pragma("unroll") for (int j = 0; j < NT_ / 2; ++j) {     \
                const bf16x8_t pbf = __builtin_bit_cast(bf16x8_t, (u32x4){pb[2 * j][0], pb[2 * j][1], pb[2 * j + 1][0], pb[2 * j + 1][1]}); \
                _Pragma("unroll") for (int i = 0; i < 8; ++i) { const unsigned char* vp = Vl + (i * 16 + lr) * 144 + ((kb_) + 32 * j + 4 * lq) * 2; \
                    const u32x2 v0 = *(const u32x2*)vp, v1 = *(const u32x2*)(vp + 32); \
                    o[i] = MFMA16(__builtin_bit_cast(bf16x8_t, (u32x4){v0.x, v0.y, v1.x, v1.y}), pbf, o[i]); } } \
            } while (0)
            if (loc && kind == 0) {
                const int k0 = min(max(mt * 16 - 8, 0), 32);
                f32x4 sv[2];
#pragma unroll
                for (int t = 0; t < 2; ++t) { sv[t] = (f32x4){0.f, 0.f, 0.f, 0.f};
#pragma unroll
                    for (int ks = 0; ks < 4; ++ks) { const bf16x8_t kb = *(const bf16x8_t*)(Kl + (k0 + t * 16 + lr) * 272 + (ks * 32 + 8 * lq) * 2); sv[t] = MFMA16(kb, qa[ks], sv[t]); } }
                const int rb = hl * 465 + (rs + b - qt + 7) * 31 + 15;
#pragma unroll
                for (int t = 0; t < 2; ++t)
#pragma unroll
                    for (int rg = 0; rg < 4; ++rg) { const int jc = k0 + t * 16 + lq * 4 + rg - cq; const bool ok = (unsigned)(jc - lo1) < 16u;
                        sv[t][rg] = ok ? sv[t][rg] + rp[rb + jc] : -1e30f; }
                ATT_TAIL(2, k0);
            } else {
                f32x4 sv[4];
#pragma unroll
                for (int t = 0; t < 4; ++t) { sv[t] = (f32x4){0.f, 0.f, 0.f, 0.f};
#pragma unroll
                    for (int ks = 0; ks < 4; ++ks) { const bf16x8_t kb = *(const bf16x8_t*)(Kl + (t * 16 + lr) * 272 + (ks * 32 + 8 * lq) * 2); sv[t] = MFMA16(kb, qa[ks], sv[t]); } }
                if (loc && (b == 0 || b == 4)) {
                    const int d0 = q0 + lr - key0 - lq * 4;
#pragma unroll
                    for (int t = 0; t < 4; ++t)
#pragma unroll
                        for (int rg = 0; rg < 4; ++rg) { const int dd = d0 - rg - 16 * t; sv[t][rg] = (abs(dd) <= 128) ? sv[t][rg] : -1e30f; }
                }
                ATT_TAIL(4, 0);
            }
#undef ATT_TAIL
            { int bn = b + 1; while (bn <= blast && !BVALID(bn)) ++bn;
              if (bn <= blast) { STAGEW(((cnt + 1) & 1) * BUF_B); __syncthreads(); int b2 = bn + 1; while (b2 <= blast && !BVALID(b2)) ++b2; if (b2 <= blast) PREFETCH(b2); } }
            ++cnt;
        }
#undef KEY0
#undef BVALID
#undef PREFETCH
#undef STAGEW
        float l = lrow; l += __shfl_xor(l, 16); l += __shfl_xor(l, 32);
        if (kind == 1) l += __builtin_amdgcn_exp2f(sinkv * 1.4426950408889634f - mrow);
        const float inv = 1.f / l;
        const int ycol = (kind == 0 ? 0 : 1024) + h * 128;
        bf16_t* yo = YM + (size_t)(q0 + lr) * DM + ycol + lq * 4;
#pragma unroll
        for (int i = 0; i < 8; ++i) { u32x2 w; w.x = pk2(o[i][0] * inv, o[i][1] * inv); w.y = pk2(o[i][2] * inv, o[i][3] * inv); *(u32x2*)(yo + i * 16) = w; }
    }
}

template <int MODE>
__device__ __forceinline__ void ph_gemm_ctx(const bf16_t* A, const bf16_t* Wt, const float* base, const float* gate, float* outf, bf16_t* outb, unsigned char* smem) {
    const int tid = TID(), lane = tid & 63, wave = tid >> 6, lr = lane & 15, lq = lane >> 4;
    constexpr int ROWB = 528, A_B = 32 * ROWB, BUF = 96 * ROWB;
    for (int bi = blockIdx.x; bi < 256; bi += gridDim.x) {
        const int r0 = (bi >> 5) * 32, c0 = (bi & 31) * 64;
        const int row0 = r0 + (wave & 1) * 16, col0 = c0 + (wave >> 1) * 16;
        u32x4 st[6];
#define GC_LOAD(kc) do { _Pragma("unroll") for (int i = 0; i < 6; ++i) { const int pc = tid + NTHR * i; const int rw = pc >> 5, c = pc & 31; \
            st[i] = rw < 32 ? *(const u32x4*)(A + (size_t)(r0 + rw) * DM + (kc) * 256 + c * 8) : *(const u32x4*)(Wt + (size_t)(c0 + rw - 32) * DM + (kc) * 256 + c * 8); } } while (0)
#define GC_STORE(bo) do { _Pragma("unroll") for (int i = 0; i < 6; ++i) { const int pc = tid + NTHR * i; *(u32x4*)(smem + (bo) + (pc >> 5) * ROWB + (pc & 31) * 16) = st[i]; } } while (0)
        GC_LOAD(0);
        __syncthreads();
        GC_STORE(0);
        __syncthreads();
        GC_LOAD(1);
        f32x4 acc = {0.f, 0.f, 0.f, 0.f}, acc2 = {0.f, 0.f, 0.f, 0.f};
#pragma unroll
        for (int kc = 0; kc < 8; ++kc) {
            const unsigned char* Al = smem + (kc & 1) * BUF + ((wave & 1) * 16 + lr) * ROWB; const unsigned char* Bl = smem + (kc & 1) * BUF + A_B + ((wave >> 1) * 16 + lr) * ROWB;
#pragma unroll
            for (int i = 0; i < 8; i += 2) {
                acc = MFMA16(*(const bf16x8_t*)(Al + (i * 32 + 8 * lq) * 2), *(const bf16x8_t*)(Bl + (i * 32 + 8 * lq) * 2), acc);
                acc2 = MFMA16(*(const bf16x8_t*)(Al + ((i + 1) * 32 + 8 * lq) * 2), *(const bf16x8_t*)(Bl + ((i + 1) * 32 + 8 * lq) * 2), acc2); }
            if (kc < 7) { GC_STORE(((kc + 1) & 1) * BUF); __syncthreads(); if (kc < 6) GC_LOAD(kc + 2); }
        }
#undef GC_LOAD
#undef GC_STORE
        acc += acc2;
#pragma unroll
        for (int rg = 0; rg < 4; ++rg) { const size_t off = (size_t)(row0 + lq * 4 + rg) * DM + col0 + lr;
            if (MODE == 0) outf[off] = base[off] + gate[col0 + lr] * acc[rg]; else outb[off] = (bf16_t)f2bf(acc[rg]); }
    }
}

#define XB_TMO      128
#define XB_XCNT(j)  (256  + 64 * (j))
#define XB_XSUB(j)  (1280 + 64 * (j))
#define XB_XGEN(j)  (2304 + 64 * (j))
#define XB_TOP      3328
#define XB_TOPGEN   3392
#define XCD_BAR_WORDS 3456
#define XB_SPIN_CAP (1u << 18)

__device__ __forceinline__ unsigned xb_ld(unsigned* p)              { return __hip_atomic_load(p, __ATOMIC_RELAXED, __HIP_MEMORY_SCOPE_AGENT); }
__device__ __forceinline__ unsigned xb_add(unsigned* p, unsigned v) { return __hip_atomic_fetch_add(p, v, __ATOMIC_RELAXED, __HIP_MEMORY_SCOPE_AGENT); }
__device__ __forceinline__ unsigned xb_xcc_id() { return (unsigned)__builtin_amdgcn_s_getreg((3 << 11) | 20) & 0xFu; }
#define XB_SPIN(cond, bar) do { unsigned _sp = 0; while (cond) { __builtin_amdgcn_s_sleep(1); \
    if ((++_sp & 255u) == 0u) { if (xb_ld(&(bar)[XB_TMO])) break; if (_sp > XB_SPIN_CAP) { atomicAdd(&(bar)[XB_TMO], 1u); break; } } } } while (0)

struct XcdBarrier {
    unsigned* bar; unsigned x;
    volatile __attribute__((address_space(3))) unsigned* st;
};

__device__ __forceinline__ XcdBarrier xcd_barrier_post(unsigned* bar, volatile __attribute__((address_space(3))) unsigned* st) {
    XcdBarrier b; b.bar = bar; b.x = xb_xcc_id(); b.st = st;
    if (TID() == 0) (void)xb_add(&bar[XB_XCNT(b.x)], 1u);
    return b;
}
__device__ __forceinline__ void xcd_barrier_complete(unsigned* bar, unsigned x, unsigned& nloc, unsigned& nx) {
    const unsigned G = gridDim.x * gridDim.y * gridDim.z;
    unsigned sum, cnt, mine, sp = 0u;
    for (;;) {
        sum = 0u; cnt = 0u; mine = 0u;
#pragma unroll
        for (unsigned j = 0; j < 16; ++j) { const unsigned c = xb_ld(&bar[XB_XCNT(j)]); sum += c; cnt += (c > 0u) ? 1u : 0u; mine = (j == x) ? c : mine; }
        if (sum == G) break;
        __builtin_amdgcn_s_sleep(1);
        if ((++sp & 255u) == 0u) { if (xb_ld(&bar[XB_TMO])) break; if (sp > XB_SPIN_CAP) { atomicAdd(&bar[XB_TMO], 1u); break; } }
    }
    nloc = mine > 0u ? mine : 1u; nx = cnt > 0u ? cnt : 1u;
}

__device__ __forceinline__ void xcd_barrier(const XcdBarrier& b) {
    asm volatile("s_waitcnt vmcnt(0)" ::: "memory");
    __syncthreads();
    if (TID() == 0) {
        unsigned* bar = b.bar;
        __builtin_amdgcn_s_waitcnt(0);
        unsigned nloc = b.st[0], nx = b.st[1];
        if (nloc == 0u) { xcd_barrier_complete(bar, b.x, nloc, nx); b.st[0] = nloc; b.st[1] = nx; }
        const unsigned old = xb_add(&bar[XB_XSUB(b.x)], 1u);
        const unsigned gen = old / nloc;
        if (old + 1u == (gen + 1u) * nloc) {
            __builtin_amdgcn_fence(__ATOMIC_RELEASE, "agent");
            asm volatile("s_waitcnt vmcnt(0)" ::: "memory");
            const unsigned og = xb_add(&bar[XB_TOP], 1u);
            const unsigned tg = og / nx;
            if (og + 1u == (tg + 1u) * nx) xb_add(&bar[XB_TOPGEN], 1u);
            else XB_SPIN(xb_ld(&bar[XB_TOPGEN]) == tg, bar);
            __builtin_amdgcn_fence(__ATOMIC_ACQUIRE, "agent");
            asm volatile("s_waitcnt vmcnt(0)" ::: "memory");
        } else {
            XB_SPIN(xb_ld(&bar[XB_TOPGEN]) == gen, bar);
            __builtin_amdgcn_fence(__ATOMIC_ACQUIRE, "agent");
            asm volatile("s_waitcnt vmcnt(0)" ::: "memory");
        }
    }
    __syncthreads();
}

enum { P_MOD = 0, P_TABLES, P_NORM_L0A, P_GEMM_AB, P_PREP_AB, P_SA, P_SB, P_SC, P_GEMM_OUT0, P_NORM_L0B, P_GEMM_Q0, P_ROUTE0, P_EXPERTS0,
       P_GEMM_CD, P_PREP_CD, P_ATTN, P_GEMM_OUT1, P_NORM_L1B, P_GEMM_Q1, P_ROUTE1, P_EXPERTS1, P_COUNT };

#ifndef PROBE_REP
#define PROBE_REP 0u
#endif
#ifndef PROBE_ABL
#define PROBE_ABL 0
#endif
template <int PH, bool DUMMY = false>
__device__ __forceinline__ void run_phase(const Params& p, unsigned char* smem) {
    float* const out_ = DUMMY ? (float*)(p.ws + OFF_SCR) : p.out;
    const float* modv = (const float*)(p.ws + OFF_MODV);
    float* XC = (float*)(p.ws + OFF_XC);
    bf16_t* H = (bf16_t*)(p.ws + OFF_H); bf16_t* YM = (bf16_t*)(p.ws + OFF_YM); bf16_t* QP = (bf16_t*)(p.ws + OFF_QP); bf16_t* PAB = (bf16_t*)(p.ws + OFF_PAB);
    if constexpr (PH == P_MOD) { ph_mod(p, smem); ph_colmax(p); }
    if constexpr (PH == P_TABLES) { if (!DUMMY) { ph_transpose_weights_i8(p, smem); __syncthreads(); } ph_transpose_weights(p, smem); ph_conv_tables(p); }
    if constexpr (PH == P_NORM_L0A) { ph_norm(p, 0, 0, p.x, p.ctx, NT, false, nullptr, nullptr, nullptr, true, false); }
    if constexpr (PH == P_GEMM_AB) { pg8::Gemm g{(const bf16_t*)(p.ws + OFF_H8), (const bf16_t*)(p.ws + OFF_WT_AB), NT, 7424, 1024}; pg8::StaticOrder S; S.init(NT, 7424, (int)gridDim.x, (int)blockIdx.x); pg8::EpiI8 E{PAB, PAB_LD, (const float*)(p.ws + OFF_HS8), (const float*)(p.ws + OFF_WSC)}; pg8::gemm_phase<pg8::EpiI8, pg8::StaticOrder, true, true, true>((PG8_LAS unsigned char*)smem, g, S, E); if (!DUMMY) tail_conv(p, 33 * 29, TAIL_RPB_AB, 2 * 16384); }
    if constexpr (PH == P_PREP_AB) ph_prep_ab(p, smem);
    if constexpr (PH == P_SA) ph_sa(p, smem, DUMMY ? PROBE_ABL : 0);
    if constexpr (PH == P_SB) { ph_sb(p); if (!DUMMY) conv_table_rows(p, 2 * 16384, 4 * 16384 - tail_rows(33 * 18, TAIL_RPB_CD), (int)blockIdx.x, (int)gridDim.x); }
    if constexpr (PH == P_SC) ph_sc(p, smem);
    if constexpr (PH == P_GEMM_OUT0) { pg8::Gemm g{YM, (const bf16_t*)(p.ws + OFF_WT_ABOUT), NL, 2048, 2048}; pg8::StaticOrder S; S.init(NL, 2048, (int)gridDim.x, (int)blockIdx.x); pg8::EpiBf16<0> E{QP, DM, nullptr, 0, 0, 1.f}; pg8::gemm_phase<pg8::EpiBf16<0>, pg8::StaticOrder, true, true>((PG8_LAS unsigned char*)smem, g, S, E); ph_gemm_ctx<1>(YM + (size_t)NL * DM, (const bf16_t*)(p.ws + OFF_WT_ABOUT), nullptr, nullptr, nullptr, QP + (size_t)NL * DM, smem); }
    if constexpr (PH == P_NORM_L0B) ph_norm(p, 0, 1, p.x, p.ctx, NT, true, QP, out_, DUMMY ? out_ : XC);
    if constexpr (PH == P_GEMM_Q0) { pg8::Gemm g{H, (const bf16_t*)(p.ws + OFF_WT_PQ0), NL, 2048, 2048}; pg8::StaticOrder S; S.init(NL, 2048, (int)gridDim.x, (int)blockIdx.x); pg8::EpiBf16<0> E{QP, DM, nullptr, 0, 0, 1.f}; pg8::gemm_phase<pg8::EpiBf16<0>, pg8::StaticOrder, true, true>((PG8_LAS unsigned char*)smem, g, S, E);  ph_gemm_ctx<1>(H + (size_t)NL * DM, (const bf16_t*)(p.ws + OFF_WT_PQ0), nullptr, nullptr, nullptr, QP + (size_t)NL * DM, smem); }
    if constexpr (PH == P_ROUTE0) ph_route(p, 0, NT, smem);
    if constexpr (PH == P_EXPERTS0) ph_experts(p, 0, NT, p.out, XC, out_, DUMMY ? out_ : XC, smem, !DUMMY, DUMMY ? PROBE_ABL : 0);
    if constexpr (PH == P_GEMM_CD) { pg8::Gemm g{(const bf16_t*)(p.ws + OFF_H8), (const bf16_t*)(p.ws + OFF_WT_CD), NT, 4608, 1024}; pg8::StaticOrder S; S.init(NT, 4608, (int)gridDim.x, (int)blockIdx.x); pg8::EpiI8 E{PAB, PCD_LD, (const float*)(p.ws + OFF_HS8), (const float*)(p.ws + OFF_WSC) + 7424}; pg8::gemm_phase<pg8::EpiI8, pg8::StaticOrder, true, true, true>((PG8_LAS unsigned char*)smem, g, S, E); if (!DUMMY) tail_conv(p, 33 * 18, TAIL_RPB_CD, 4 * 16384); }
    if constexpr (PH == P_PREP_CD) ph_prep_cd(p, smem);
    if constexpr (PH == P_ATTN) ph_attn(p, smem);
    if constexpr (PH == P_GEMM_OUT1) { pg8::Gemm g{YM, (const bf16_t*)(p.ws + OFF_WT_CDOUT), NL, 2048, 2048}; pg8::StaticOrder S; S.init(NL, 2048, (int)gridDim.x, (int)blockIdx.x); pg8::EpiBf16<0> E{QP, DM, nullptr, 0, 0, 1.f}; pg8::gemm_phase<pg8::EpiBf16<0>, pg8::StaticOrder, true, true>((PG8_LAS unsigned char*)smem, g, S, E); }
    if constexpr (PH == P_NORM_L1B) ph_norm(p, 1, 1, p.out, XC, NL, true, QP, out_, XC);
    if constexpr (PH == P_GEMM_Q1) { pg8::Gemm g{H, (const bf16_t*)(p.ws + OFF_WT_PQ1), NL, 2048, 2048}; pg8::StaticOrder S; S.init(NL, 2048, (int)gridDim.x, (int)blockIdx.x); pg8::EpiBf16<0> E{QP, DM, nullptr, 0, 0, 1.f}; pg8::gemm_phase<pg8::EpiBf16<0>, pg8::StaticOrder, true, true>((PG8_LAS unsigned char*)smem, g, S, E); }
    if constexpr (PH == P_ROUTE1) ph_route(p, 1, NL, smem);
    if constexpr (PH == P_EXPERTS1) ph_experts_w(p, 1, NL, p.out, out_, smem, false);
}

constexpr int LDS_BYTES = 163840;
template <int PH> __device__ __forceinline__ void run_from(const Params& p, unsigned char* smem, cg::grid_group& grid, const XcdBarrier& bar) {
    run_phase<PH>(p, smem);
    if constexpr (((PROBE_REP >> PH) & 1u) != 0u && PH != P_SB && PH != P_MOD) { xcd_barrier(bar); run_phase<PH, true>(p, smem); }
    if constexpr (PH + 1 < P_COUNT) {
        if constexpr (PH == P_MOD) { __syncthreads(); grid.sync(); }
        else if constexpr (PH == P_TABLES) __syncthreads();
        else xcd_barrier(bar);
        run_from<PH + 1>(p, smem, grid, bar);
    }
}
__global__ void __launch_bounds__(NTHR, 2) k_all(Params p) {
    extern __shared__ __attribute__((aligned(16))) unsigned char smem[];
    cg::grid_group grid = cg::this_grid();
    volatile __attribute__((address_space(3))) unsigned* st = (volatile __attribute__((address_space(3))) unsigned*)((__attribute__((address_space(3))) unsigned char*)smem + LDS_BYTES - 64);
    if (TID() < 16) st[TID()] = 0u;
    __syncthreads();
    const XcdBarrier bar = xcd_barrier_post((unsigned*)(p.ws + OFF_CTL), st);
    run_from<0>(p, smem, grid, bar);
}

extern "C" void kernel_launch(void* const* d_in, const int* in_sizes, int n_in, void* d_out, int out_size, void* d_ws, size_t ws_size, hipStream_t stream) {
    static int grid_blocks = 0;
    if (!grid_blocks) {
        int dev = 0, cus = 0, per_cu = 0;
        (void)hipGetDevice(&dev);
        (void)hipDeviceGetAttribute(&cus, hipDeviceAttributeMultiprocessorCount, dev);
        (void)hipFuncSetAttribute((const void*)k_all, hipFuncAttributeMaxDynamicSharedMemorySize, LDS_BYTES);
        (void)hipOccupancyMaxActiveBlocksPerMultiprocessor(&per_cu, (const void*)k_all, NTHR, LDS_BYTES);
        if (per_cu < 1) per_cu = 1;
        if (per_cu > 1) per_cu = 1;
        grid_blocks = cus * per_cu;
    }
    Params p{};
    const float** pp = (const float**)&p;
    for (int i = 0; i < 24; ++i) pp[i] = (const float*)d_in[i];
    p.out = (float*)d_out; p.ws = (unsigned char*)d_ws;
    (void)hipMemsetAsync((char*)d_ws + OFF_CTL, 0, CTL_BYTES, stream);
    void* args[] = {&p};
    hipError_t e = hipLaunchCooperativeKernel((const void*)k_all, dim3(grid_blocks), dim3(NTHR), args, LDS_BYTES, stream);
    if (e != hipSuccess) fprintf(stderr, "cooperative launch failed: %s (grid %d)\n", hipGetErrorString(e), grid_blocks);
}
```
